# Optimizing an MI355X kernel written in HIP

```python
import math
import jax
import jax.numpy as jnp
from jax import lax
import numpy as np

D_MODEL = 1024
BATCH = 16
SEQ = 2048
DEPTH = 1

GRID_W = 64
CTX_LEN = 256
DA_HEADS = 8
DA_HEAD_DIM = 64
DA_V_DIM = 2 * DA_HEAD_DIM
DA_WIDTH = DA_HEADS * 2 * DA_HEAD_DIM
LRU_WIDTH = D_MODEL
LRU_BLOCKS = 16
LRU_BLOCK_DIM = LRU_WIDTH // LRU_BLOCKS
CONV_WIDTH = 4
CONV_PAD_LEFT = (CONV_WIDTH - 1) // 2
CONV_PAD_RIGHT = CONV_WIDTH - 1 - CONV_PAD_LEFT
LRU_C = 8.0
ROPE_THETA = 10000.0
Q_BLOCK = 128
NORM_EPS = 1e-6
N_BRANCHES = 2
IN_COLS = 4 * DA_WIDTH + 2 * LRU_WIDTH + N_BRANCHES * D_MODEL

kernel_name = 'hybrid_diffattn_rglru_prefix_dit_block'


def _rmsnorm(x, g):
    xf = x.astype(jnp.float32)
    y = xf * lax.rsqrt(jnp.mean(xf * xf, axis=-1, keepdims=True) + NORM_EPS)
    return (y * g.astype(jnp.float32)).astype(x.dtype)


def _lambda_init(layer_idx):
    return 0.8 - 0.6 * math.exp(-0.3 * layer_idx)


def _split_in(p):
    widths = (DA_WIDTH, DA_WIDTH, DA_WIDTH, DA_WIDTH, LRU_WIDTH, LRU_WIDTH, N_BRANCHES * D_MODEL)
    offsets = np.cumsum(widths)[:-1].tolist()
    return jnp.split(p, offsets, axis=-1)


def _axial_rope_tables(n_tokens):
    rows = n_tokens // GRID_W
    row = jnp.repeat(jnp.arange(rows, dtype=jnp.float32), GRID_W)
    col = jnp.tile(jnp.arange(GRID_W, dtype=jnp.float32), rows)
    axis_dim = DA_HEAD_DIM // 2
    inv_freq = ROPE_THETA ** (-jnp.arange(0, axis_dim, 2, dtype=jnp.float32) / axis_dim)
    ang_r = row[:, None] * inv_freq[None, :]
    ang_c = col[:, None] * inv_freq[None, :]
    return (jnp.cos(ang_r), jnp.sin(ang_r), jnp.cos(ang_c), jnp.sin(ang_c))


def _rotate(x, cos, sin):
    x1, x2 = jnp.split(x, 2, axis=-1)
    cs = cos[:, None, None, :]
    sn = sin[:, None, None, :]
    return jnp.concatenate([x1 * cs - x2 * sn, x1 * sn + x2 * cs], axis=-1)


def _apply_axial_rope(x, tables):
    cr, sr, cc, sc = tables
    half = DA_HEAD_DIM // 2
    xf = x.astype(jnp.float32)
    out = jnp.concatenate([_rotate(xf[..., :half], cr, sr), _rotate(xf[..., half:], cc, sc)], axis=-1)
    return out.astype(x.dtype)


def _diff_attend(q, k, v, lam):
    s = jnp.einsum('bqhjd,bkhjd->bhjqk', q, k, preferred_element_type=jnp.float32) * (DA_HEAD_DIM ** -0.5)
    p = jax.nn.softmax(s, axis=-1)
    w = p[:, :, 0] - lam * p[:, :, 1]
    return jnp.einsum('bhqk,bkhe->bqhe', w.astype(v.dtype), v)


def _latent_diff_attention(q_lat, k_all, v_all, lam):
    b, n = q_lat.shape[:2]
    n_blk = n // Q_BLOCK
    qb = q_lat.reshape(b, n_blk, Q_BLOCK, DA_HEADS, 2, DA_HEAD_DIM).swapaxes(0, 1)
    out = lax.map(lambda qq: _diff_attend(qq, k_all, v_all, lam), qb)
    return out.swapaxes(0, 1).reshape(b, n, DA_HEADS, DA_V_DIM)


def _diff_head_out(o, g_subln, lam_init):
    o = _rmsnorm(o, g_subln) * (1.0 - lam_init)
    return o.reshape(o.shape[0], o.shape[1], DA_WIDTH)


def _centred_dwconv(x, w, b):
    n = x.shape[1]
    xp = jnp.pad(x, ((0, 0), (CONV_PAD_LEFT, CONV_PAD_RIGHT), (0, 0)))
    y = b
    for j in range(CONV_WIDTH):
        y = y + xp[:, j:j + n] * w[j]
    return y


def _rglru_coeffs(xc, w_a, b_a, w_x, b_x, lam):
    b, n, _ = xc.shape
    xb = xc.reshape(b, n, LRU_BLOCKS, LRU_BLOCK_DIM)
    r = jax.nn.sigmoid((jnp.einsum('blni,nij->blnj', xb, w_a).reshape(b, n, LRU_WIDTH) + b_a).astype(jnp.float32))
    i = jax.nn.sigmoid((jnp.einsum('blni,nij->blnj', xb, w_x).reshape(b, n, LRU_WIDTH) + b_x).astype(jnp.float32))
    log_a = -LRU_C * r * jax.nn.softplus(-lam.astype(jnp.float32))
    a = jnp.exp(log_a)
    mult = jnp.sqrt(-jnp.expm1(2.0 * log_a))
    return a, mult * i * xc.astype(jnp.float32)


def _linear_scan(a, u, h0):
    def combine(e1, e2):
        return (e1[0] * e2[0], e2[0] * e1[1] + e2[1])
    a_cum, u_cum = lax.associative_scan(combine, (a, u), axis=1)
    return a_cum * h0[:, None, :] + u_cum


def _rglru_direction(xc_ctx, xc_lat, w_a, b_a, w_x, b_x, lam, reverse):
    a_c, u_c = _rglru_coeffs(xc_ctx, w_a, b_a, w_x, b_x, lam)
    a_l, u_l = _rglru_coeffs(xc_lat, w_a, b_a, w_x, b_x, lam)
    if reverse:
        a_c, u_c, a_l, u_l = (jnp.flip(a_c, 1), jnp.flip(u_c, 1), jnp.flip(a_l, 1), jnp.flip(u_l, 1))
    h_c = _linear_scan(a_c, u_c, jnp.zeros_like(u_c[:, 0]))
    h_l = _linear_scan(a_l, u_l, h_c[:, -1])
    if reverse:
        h_c, h_l = (jnp.flip(h_c, 1), jnp.flip(h_l, 1))
    return h_c, h_l


def _merge_branches(attn, lru, gate_attn, gate_lru, gate_merge, w_attn_out, w_lru_out, w_out):
    y_attn = (attn * jax.nn.silu(gate_attn)) @ w_attn_out
    y_lru = (lru * jax.nn.silu(gate_lru)) @ w_lru_out
    m_attn, m_lru = jnp.split(jax.nn.sigmoid(gate_merge), N_BRANCHES, axis=-1)
    return (m_attn * y_attn + m_lru * y_lru) @ w_out


def setup_inputs(seed: int = 0) -> dict:
    key = jax.random.key(seed)
    ks = jax.random.split(key, 24)
    f32 = jnp.float32

    def nrm(k, shape, scale):
        return jax.random.normal(k, shape, f32) * scale

    u = jax.random.uniform(ks[21], (DEPTH, 2, LRU_WIDTH), f32, 0.9, 0.999)
    a0 = u ** (1.0 / LRU_C)
    return {
        'x': nrm(ks[0], (BATCH, SEQ, D_MODEL), 1.0),
        'c': nrm(ks[1], (BATCH, D_MODEL), 1.0),
        'ctx': nrm(ks[2], (BATCH, CTX_LEN, D_MODEL), 1.0),
        'c_ctx': nrm(ks[3], (D_MODEL,), 1.0),
        'w_mod': nrm(ks[4], (DEPTH, D_MODEL, 3 * D_MODEL), D_MODEL ** -0.5),
        'b_mod': nrm(ks[5], (DEPTH, 3 * D_MODEL), 0.02),
        'g_pre': 1.0 + nrm(ks[6], (DEPTH, D_MODEL), 0.05),
        'g_post': 1.0 + nrm(ks[7], (DEPTH, D_MODEL), 0.05),
        'w_in': nrm(ks[8], (DEPTH, D_MODEL, IN_COLS), D_MODEL ** -0.5),
        'lambda_q1': nrm(ks[9], (DEPTH, DA_HEAD_DIM), 0.1),
        'lambda_k1': nrm(ks[10], (DEPTH, DA_HEAD_DIM), 0.1),
        'lambda_q2': nrm(ks[11], (DEPTH, DA_HEAD_DIM), 0.1),
        'lambda_k2': nrm(ks[12], (DEPTH, DA_HEAD_DIM), 0.1),
        'g_subln': 1.0 + nrm(ks[13], (DEPTH, DA_V_DIM), 0.05),
        'w_attn_out': nrm(ks[14], (DEPTH, DA_WIDTH, D_MODEL), DA_WIDTH ** -0.5),
        'conv_w': nrm(ks[15], (DEPTH, CONV_WIDTH, LRU_WIDTH), CONV_WIDTH ** -0.5),
        'conv_b': nrm(ks[16], (DEPTH, LRU_WIDTH), 0.02),
        'w_rg_a': nrm(ks[17], (DEPTH, 2, LRU_BLOCKS, LRU_BLOCK_DIM, LRU_BLOCK_DIM), LRU_BLOCK_DIM ** -0.5),
        'b_rg_a': nrm(ks[18], (DEPTH, 2, LRU_WIDTH), 0.02),
        'w_rg_x': nrm(ks[19], (DEPTH, 2, LRU_BLOCKS, LRU_BLOCK_DIM, LRU_BLOCK_DIM), LRU_BLOCK_DIM ** -0.5),
        'b_rg_x': nrm(ks[20], (DEPTH, 2, LRU_WIDTH), 0.02),
        'lru_lambda': jnp.log(a0) - jnp.log1p(-a0),
        'w_lru_out': nrm(ks[22], (DEPTH, LRU_WIDTH, D_MODEL), LRU_WIDTH ** -0.5),
        'w_out': nrm(ks[23], (DEPTH, D_MODEL, D_MODEL), D_MODEL ** -0.5),
    }


def reference(x, c, ctx, c_ctx, w_mod, b_mod, g_pre, g_post, w_in, lambda_q1, lambda_k1, lambda_q2, lambda_k2,
              g_subln, w_attn_out, conv_w, conv_b, w_rg_a, b_rg_a, w_rg_x, b_rg_x, lru_lambda, w_lru_out, w_out):
    b, n = x.shape[:2]
    nc = ctx.shape[1]
    rope = _axial_rope_tables(n)
    silu_c = jax.nn.silu(c)
    silu_cc = jax.nn.silu(c_ctx)
    for l in range(DEPTH):
        last = l == DEPTH - 1
        shift_l, scale_l, gate_l = jnp.split((silu_c @ w_mod[l] + b_mod[l])[:, None, :], 3, axis=-1)
        shift_c, scale_c, gate_c = jnp.split(silu_cc @ w_mod[l] + b_mod[l], 3, axis=-1)
        h = _rmsnorm(x, g_pre[l]) * (1.0 + scale_l) + shift_l
        hc = _rmsnorm(ctx, g_pre[l]) * (1.0 + scale_c) + shift_c
        q, k, v, ga, xr, gr, gm = _split_in(h @ w_in[l])
        qc, kc, vc, gac, xrc, grc, gmc = _split_in(hc @ w_in[l])
        q = _apply_axial_rope(q.reshape(b, n, DA_HEADS, 2, DA_HEAD_DIM), rope)
        k = _apply_axial_rope(k.reshape(b, n, DA_HEADS, 2, DA_HEAD_DIM), rope)
        v = v.reshape(b, n, DA_HEADS, DA_V_DIM)
        kc = kc.reshape(b, nc, DA_HEADS, 2, DA_HEAD_DIM)
        vc = vc.reshape(b, nc, DA_HEADS, DA_V_DIM)
        lam_init = _lambda_init(l)
        lam = (jnp.exp(jnp.sum(lambda_q1[l].astype(jnp.float32) * lambda_k1[l].astype(jnp.float32)))
               - jnp.exp(jnp.sum(lambda_q2[l].astype(jnp.float32) * lambda_k2[l].astype(jnp.float32))) + lam_init)
        k_all = jnp.concatenate([kc, k], axis=1)
        v_all = jnp.concatenate([vc, v], axis=1)
        attn_lat = _diff_head_out(_latent_diff_attention(q, k_all, v_all, lam), g_subln[l], lam_init)
        xr_l = _centred_dwconv(xr, conv_w[l], conv_b[l])
        xr_c = _centred_dwconv(xrc, conv_w[l], conv_b[l])
        hf_c, hf_l = _rglru_direction(xr_c, xr_l, w_rg_a[l, 0], b_rg_a[l, 0], w_rg_x[l, 0], b_rg_x[l, 0], lru_lambda[l, 0], False)
        hb_c, hb_l = _rglru_direction(xr_c, xr_l, w_rg_a[l, 1], b_rg_a[l, 1], w_rg_x[l, 1], b_rg_x[l, 1], lru_lambda[l, 1], True)
        lru_lat = (hf_l + hb_l).astype(x.dtype)
        y = _merge_branches(attn_lat, lru_lat, ga, gr, gm, w_attn_out[l], w_lru_out[l], w_out[l])
        x_new = x + gate_l * _rmsnorm(y, g_post[l])
        if not last:
            qc = qc.reshape(b, nc, DA_HEADS, 2, DA_HEAD_DIM)
            attn_ctx = _diff_head_out(_diff_attend(qc, kc, vc, lam), g_subln[l], lam_init)
            lru_ctx = (hf_c + hb_c).astype(ctx.dtype)
            yc = _merge_branches(attn_ctx, lru_ctx, gac, grc, gmc, w_attn_out[l], w_lru_out[l], w_out[l])
            ctx = ctx + gate_c * _rmsnorm(yc, g_post[l])
        x = x_new
    return x
```

```cpp
#include <hip/hip_runtime.h>
#include <hip/hip_cooperative_groups.h>
#include <cstdio>
#include <cstdint>
namespace cg = cooperative_groups;
namespace pg8 {
#define PG8_LAS __attribute__((address_space(3)))
typedef unsigned short bf16_t;
typedef short bf16x8 __attribute__((ext_vector_type(8)));
typedef float f32x4 __attribute__((ext_vector_type(4)));
typedef unsigned u32x4 __attribute__((ext_vector_type(4)));
constexpr int BM = 256, BK = 64, HALF = 128, HTB = HALF * BK * 2  , STAGE_BYTES = 8 * HTB, NXCD = 8, WGM = 8;

__host__ __device__ __forceinline__ int lds_byte(int r, int c) { const int st = (r >> 4) * 2 + (c >> 5), rr = r & 15, cc = c & 31, ob = rr * 64 + cc * 2; return st * 1024 + (ob ^ (((ob >> 9) & 1) << 5)); }
__host__ __device__ __forceinline__ void stage_rc(int b, int& R, int& C) { const int st = b / 1024, sb = b % 1024, swz = sb ^ (((sb >> 9) & 1) << 5); R = (st >> 1) * 16 + swz / 64; C = (st & 1) * 32 + (swz % 64) / 2; }
__host__ __device__ __forceinline__ int perm32(int rho) { const int n = rho >> 4, i = rho & 15; return 8 * (i >> 2) + 4 * n + (i & 3); }

struct Unit { int pm, pn; };
struct Gemm { const bf16_t* A; const bf16_t* Bt; int M, N, K; };

struct StaticOrder {
    int nM, nN, nwg, G, c;
    __host__ __device__ void init(int M, int N, int G_, int c_) { nM = M / BM; nN = N / BM; nwg = nM * nN; G = G_; c = c_; }
    __host__ __device__ bool next(int i, Unit& u) const {
        const long L = (long)i * G + c; if (L >= nwg) return false;
        int wgid = (int)L; { const int q = nwg / NXCD, r = nwg % NXCD, xcd = wgid % NXCD, off = wgid / NXCD; wgid = (xcd < r ? xcd * (q + 1) : r * (q + 1) + (xcd - r) * q) + off; }
        const int nig = WGM * nN, gid = wgid / nig, fm = gid * WGM, gsz = (nM - fm) < WGM ? (nM - fm) : WGM;
        u.pm = fm + ((wgid % nig) % gsz); u.pn = (wgid % nig) / gsz; return true;
    }
    __device__ __forceinline__ void a_ready(const Unit&) const {}
    __device__ __forceinline__ void done(const Unit&) const {}
};

__device__ __forceinline__ unsigned cvt_pk_bf16(float lo, float hi) { unsigned r; asm volatile("v_cvt_pk_bf16_f32 %0, %1, %2" : "=v"(r) : "v"(lo), "v"(hi)); return r; }
typedef float f32x2 __attribute__((ext_vector_type(2)));
template <class Epi, class Sched, bool ALIGN_EPI = false, bool SP2 = false>
__device__ __forceinline__ void gemm_phase(PG8_LAS unsigned char* lds, const Gemm g, const Sched& S, const Epi& E) {
    int tid_ = threadIdx.x; asm volatile("" : "+v"(tid_));
    const int tid = tid_, wid = __builtin_amdgcn_readfirstlane(tid >> 6), lane = tid & 63, wr = wid >> 2, wc = wid & 3, fr = lane & 15, fq = lane >> 4;
    const int K = g.K, nt = K / BK;
    unsigned voffA[2], voffB[2];
#pragma unroll
    for (int i = 0; i < 2; ++i) { int R, C; stage_rc(tid * 16 + i * 8192, R, C); const int Rb = Epi::PERM ? ((R & ~31) + perm32(R & 31)) : R;
        voffA[i] = (unsigned)(R * K + C) * 2u; voffB[i] = (unsigned)(Rb * K + C) * 2u; }
    const size_t kstep = (size_t)(BK * 2);
    const size_t hstep = (size_t)HALF * K * 2;
    const size_t tstep = 2 * hstep;
    const unsigned ldsw = (unsigned)wid * 1024u;
    const int aoff = lds_byte(wr * 64 + fr, fq * 8), boff = lds_byte(wc * 32 + fr, fq * 8);
#define PG8_SA(b, h) (((b) * 2 + (h)) * HTB)
#define PG8_SB(b, h) ((4 + (b) * 2 + (h)) * HTB)
#define PG8_STAGE(bufoff, gbase, voff) do { _Pragma("unroll") for (int _i = 0; _i < 2; ++_i) \
        __builtin_amdgcn_global_load_lds((const unsigned*)((const char*)(gbase) + (voff)[_i]), (PG8_LAS unsigned*)(lds + (bufoff) + ldsw + _i * 8192), 16, 0, 0); } while (0)
#define PG8_LDA(dst, b, h) do { _Pragma("unroll") for (int m = 0; m < 4; ++m) _Pragma("unroll") for (int k = 0; k < 2; ++k) dst[m][k] = *(const PG8_LAS bf16x8*)(lds + PG8_SA(b, h) + aoff + m * 2048 + k * 1024); } while (0)
#define PG8_LDB(dst, b, h) do { _Pragma("unroll") for (int n = 0; n < 2; ++n) _Pragma("unroll") for (int k = 0; k < 2; ++k) dst[n][k] = *(const PG8_LAS bf16x8*)(lds + PG8_SB(b, h) + boff + n * 2048 + k * 1024); } while (0)
#define PG8_MMA(ai, bj, At, Bt) do { __builtin_amdgcn_s_setprio(1); _Pragma("unroll") for (int m = 0; m < 4; ++m) _Pragma("unroll") for (int n = 0; n < 2; ++n) _Pragma("unroll") for (int k = 0; k < 2; ++k) \
        acc[ai][bj][m][n] = __builtin_amdgcn_mfma_f32_16x16x32_bf16(Bt[n][k], At[m][k], acc[ai][bj][m][n], 0, 0, 0); __builtin_amdgcn_s_setprio(0); } while (0)
#define PG8_WAIT_V(n) asm volatile("s_waitcnt vmcnt(" #n ")" ::: "memory")
#define PG8_WAIT_L(n) asm volatile("s_waitcnt lgkmcnt(" #n ")" ::: "memory")
#define PG8_BAR __builtin_amdgcn_s_barrier()
#define PG8_SCHED __builtin_amdgcn_sched_barrier(0)
    Unit cur, nxt; int ui = 0;
    if (!S.next(0, cur)) return;
    f32x4 acc[2][2][4][2];
#pragma unroll
    for (int a = 0; a < 2; ++a)
#pragma unroll
        for (int b = 0; b < 2; ++b)
#pragma unroll
            for (int m = 0; m < 4; ++m)
#pragma unroll
                for (int n = 0; n < 2; ++n) acc[a][b][m][n] = (f32x4){0.f, 0.f, 0.f, 0.f};
    bf16x8 At[4][2], B0[2][2], B1[2][2];
    const char* cA = (const char*)g.A + (size_t)cur.pm * tstep; const char* cB = (const char*)g.Bt + (size_t)cur.pn * tstep;
    S.a_ready(cur);
    if constexpr (SP2) {
        PG8_STAGE(PG8_SB(0, 0), cB, voffB); PG8_STAGE(PG8_SB(0, 1), cB + hstep, voffB); PG8_STAGE(PG8_SA(0, 0), cA, voffA); PG8_STAGE(PG8_SA(0, 1), cA + hstep, voffA);
        if (wr == 1) PG8_BAR;
        PG8_WAIT_V(2); PG8_BAR;
        PG8_STAGE(PG8_SB(1, 0), cB + kstep, voffB); PG8_STAGE(PG8_SA(1, 0), cA + kstep, voffA); PG8_STAGE(PG8_SB(1, 1), cB + hstep + kstep, voffB);
        PG8_WAIT_V(6); PG8_BAR;
    } else {
        PG8_STAGE(PG8_SB(0, 0), cB, voffB); PG8_STAGE(PG8_SA(0, 0), cA, voffA); PG8_STAGE(PG8_SB(0, 1), cB + hstep, voffB); PG8_STAGE(PG8_SA(0, 1), cA + hstep, voffA);
        if (wr == 1) PG8_BAR;
        PG8_WAIT_V(4); PG8_BAR;
        PG8_STAGE(PG8_SB(1, 0), cB + kstep, voffB); PG8_STAGE(PG8_SA(1, 0), cA + kstep, voffA); PG8_STAGE(PG8_SB(1, 1), cB + hstep + kstep, voffB);
        PG8_WAIT_V(6); PG8_BAR;
    }
    for (;;) {
        const bool has_next = S.next(ui + 1, nxt);
        const char* nA = has_next ? (const char*)g.A + (size_t)nxt.pm * tstep : cA; const char* nB = has_next ? (const char*)g.Bt + (size_t)nxt.pn * tstep : cB;
        for (int t = 0; t < nt; t += 2) {
            const bool last = (t == nt - 2);
            const char* a1 = cA + (size_t)(t + 1) * kstep;
            const char* a2 = last ? nA : cA + (size_t)(t + 2) * kstep; const char* b2 = last ? nB : cB + (size_t)(t + 2) * kstep;
            const char* a3 = a2 + kstep; const char* b3 = b2 + kstep;
            if (last && has_next) S.a_ready(nxt);
            if constexpr (SP2) {
            PG8_LDB(B0, 0, 0); PG8_LDB(B1, 0, 1); PG8_SCHED; PG8_LDA(At, 0, 0); PG8_STAGE(PG8_SA(1, 1), a1 + hstep, voffA);
            PG8_WAIT_V(8); PG8_WAIT_L(0); PG8_BAR; PG8_MMA(0, 0, At, B0); PG8_MMA(0, 1, At, B1); PG8_BAR; PG8_SCHED;
            PG8_LDA(At, 0, 1); PG8_STAGE(PG8_SB(0, 0), b2, voffB); PG8_STAGE(PG8_SB(0, 1), b2 + hstep, voffB); PG8_STAGE(PG8_SA(0, 0), a2, voffA);
            PG8_WAIT_V(8); PG8_WAIT_L(0); PG8_BAR; PG8_MMA(1, 0, At, B0); PG8_MMA(1, 1, At, B1); PG8_BAR; PG8_SCHED;
            PG8_LDB(B0, 1, 0); PG8_LDB(B1, 1, 1); PG8_SCHED; PG8_LDA(At, 1, 0); PG8_STAGE(PG8_SA(0, 1), a2 + hstep, voffA);
            PG8_WAIT_V(8); PG8_WAIT_L(0); PG8_BAR; PG8_MMA(0, 0, At, B0); PG8_MMA(0, 1, At, B1); PG8_BAR; PG8_SCHED;
            PG8_LDA(At, 1, 1); PG8_STAGE(PG8_SB(1, 0), b3, voffB); PG8_STAGE(PG8_SB(1, 1), b3 + hstep, voffB); PG8_STAGE(PG8_SA(1, 0), a3, voffA);
            PG8_WAIT_V(8); PG8_WAIT_L(0); PG8_BAR; PG8_MMA(1, 0, At, B0); PG8_MMA(1, 1, At, B1); PG8_BAR; PG8_SCHED;
            } else {
            PG8_LDB(B0, 0, 0); PG8_SCHED; PG8_LDA(At, 0, 0); PG8_STAGE(PG8_SA(1, 1), a1 + hstep, voffA);
            PG8_WAIT_L(8); PG8_BAR; PG8_WAIT_L(0); PG8_MMA(0, 0, At, B0); PG8_BAR; PG8_SCHED;
            PG8_LDB(B1, 0, 1); PG8_STAGE(PG8_SB(0, 0), b2, voffB);
            PG8_BAR; PG8_WAIT_L(0); PG8_MMA(0, 1, At, B1); PG8_BAR;
            PG8_LDA(At, 0, 1); PG8_STAGE(PG8_SA(0, 0), a2, voffA);
            PG8_BAR; PG8_WAIT_L(0); PG8_MMA(1, 0, At, B0); PG8_BAR; PG8_SCHED;
            PG8_STAGE(PG8_SB(0, 1), b2 + hstep, voffB);
            PG8_WAIT_V(6); PG8_BAR; PG8_MMA(1, 1, At, B1); PG8_BAR;
            PG8_LDB(B0, 1, 0); PG8_SCHED; PG8_LDA(At, 1, 0); PG8_STAGE(PG8_SA(0, 1), a2 + hstep, voffA);
            PG8_WAIT_L(8); PG8_BAR; PG8_WAIT_L(0); PG8_MMA(0, 0, At, B0); PG8_BAR; PG8_SCHED;
            PG8_LDB(B1, 1, 1); PG8_STAGE(PG8_SB(1, 0), b3, voffB);
            PG8_BAR; PG8_WAIT_L(0); PG8_MMA(0, 1, At, B1); PG8_BAR;
            PG8_LDA(At, 1, 1); PG8_STAGE(PG8_SA(1, 0), a3, voffA);
            PG8_BAR; PG8_WAIT_L(0); PG8_MMA(1, 0, At, B0); PG8_BAR; PG8_SCHED;
            PG8_STAGE(PG8_SB(1, 1), b3 + hstep, voffB);
            PG8_WAIT_V(6); PG8_BAR; PG8_MMA(1, 1, At, B1); PG8_BAR;
            }
        }
        if constexpr (ALIGN_EPI) { if (wr == 0) PG8_BAR; }
        if constexpr (!Epi::AFTER_DRAIN) { E(acc, cur, wr, wc, fr, fq); S.done(cur); }
        if (!has_next) break;
        if (!E.chain(cur)) {
#pragma unroll
        for (int a = 0; a < 2; ++a)
#pragma unroll
            for (int b = 0; b < 2; ++b)
#pragma unroll
                for (int m = 0; m < 4; ++m)
#pragma unroll
                    for (int n = 0; n < 2; ++n) acc[a][b][m][n] = (f32x4){0.f, 0.f, 0.f, 0.f};
        }
        cur = nxt; cA = nA; cB = nB; ++ui;
        if constexpr (ALIGN_EPI) { if (wr == 1) PG8_BAR; }
    }
    PG8_WAIT_V(0);
    if constexpr (!ALIGN_EPI) { if (wr == 0) PG8_BAR; }
    PG8_BAR;
    if constexpr (Epi::AFTER_DRAIN) { E.fused(acc, cur, wr, wc, fr, fq, lds, wid, lane); S.done(cur); }
#undef PG8_SA
#undef PG8_SB
#undef PG8_STAGE
#undef PG8_LDA
#undef PG8_LDB
#undef PG8_MMA
#undef PG8_WAIT_V
#undef PG8_WAIT_L
#undef PG8_BAR
#undef PG8_SCHED
}
}

constexpr int NB = 16, SEQ = 2048, DM = 1024, CTXL = 256, LALL = SEQ + CTXL;
constexpr int ML = NB * SEQ, MC = NB * CTXL, MALL = ML + MC;
constexpr int NIN = 8192, NHEAD = 8;
constexpr float NORM_EPS = 1e-6f;
constexpr float LAM_INIT = 0.2f;

#define LAS __attribute__((address_space(3)))
typedef pg8::bf16_t bf16_t;
typedef pg8::bf16x8 bf16x8;
typedef pg8::f32x4 f32x4;
typedef pg8::u32x4 u32x4;
typedef float f32x16 __attribute__((ext_vector_type(16)));
typedef float f32x2 __attribute__((ext_vector_type(2)));
typedef unsigned u32x2 __attribute__((ext_vector_type(2)));
typedef short s16x4 __attribute__((ext_vector_type(4)));
typedef __bf16 bf16x2_t __attribute__((ext_vector_type(2)));

constexpr size_t MiB = 1u << 20;
constexpr size_t WS_MODF = 0;
constexpr size_t WS_ROPE = 256 * 1024;
constexpr size_t WS_BAR = 1 * MiB, WS_BAR_BYTES = 16384;
constexpr int LDS_BARW = 131072 + 64;
constexpr size_t WS_WIN = 2 * MiB;
constexpr size_t WS_WA = 18 * MiB, WS_WL = 20 * MiB, WS_WO = 22 * MiB;
constexpr size_t WS_XN = 24 * MiB;
constexpr size_t WS_Q = 96 * MiB;
constexpr size_t WS_GR = 160 * MiB;
constexpr size_t WS_GA = 224 * MiB;
constexpr size_t WS_KA = 288 * MiB;
constexpr size_t WS_VA = 360 * MiB;
constexpr size_t WS_T = 288 * MiB;
constexpr size_t WS_XR = 432 * MiB;
constexpr size_t WS_PART = 504 * MiB;
constexpr size_t WS_END = 506 * MiB;

constexpr int LDS_BYTES = 147456;

__device__ __forceinline__ unsigned pk_bf16(float lo, float hi) { f32x2 v = {lo, hi}; bf16x2_t b = __builtin_convertvector(v, bf16x2_t); return __builtin_bit_cast(unsigned, b); }
__device__ __forceinline__ float bf_lo(unsigned u) { return __uint_as_float(u << 16); }
__device__ __forceinline__ float bf_hi(unsigned u) { return __uint_as_float(u & 0xffff0000u); }
__device__ __forceinline__ float sigmoidf_(float v) { return __builtin_amdgcn_rcpf(1.0f + __builtin_amdgcn_exp2f(-1.4426950408889634f * v)); }
__device__ __forceinline__ float siluf_(float v) { return v * sigmoidf_(v); }
#define LDS_BARRIER() do { asm volatile("s_waitcnt lgkmcnt(0)" ::: "memory"); __builtin_amdgcn_s_barrier(); asm volatile("" ::: "memory"); } while (0)

struct InProjOrder {
    pg8::StaticOrder S; int G, c;
    __device__ void init(int G_, int c_) { S.init(ML, NIN, G_, c_); G = G_; c = c_; }
    __device__ bool next(int i, pg8::Unit& u) const {
        const long L = (long)i * G + c;
        if (L < 4096) return S.next(i, u);
        const int j = (int)(L - 4096); if (j >= 192) return false;
        u.pm = 128 + (j & 15); const int q = j >> 4; u.pn = q < 8 ? 4 + q : 8 + q;
        return true;
    }
    __device__ __forceinline__ void a_ready(const pg8::Unit&) const {}
    __device__ __forceinline__ void done(const pg8::Unit&) const {}
};

struct EpiInProj {
    static constexpr bool PERM = true, AFTER_DRAIN = false;
    __device__ __forceinline__ bool chain(const pg8::Unit&) const { return false; }
    bf16_t *Q, *KA, *VA, *GA, *XR, *GR, *GM; const f32x2* rope;
    __device__ __forceinline__ void operator()(const f32x4 (&acc)[2][2][4][2], const pg8::Unit& u, int wr, int wc, int fr, int fq) const {
        const int pn = u.pn, pm = u.pm;
        const bool lat = pm < 128;
        const int b = lat ? (pm >> 3) : (pm - 128);
        const int tb = lat ? ((pm & 7) << 8) : 0;
        const int seg = pn >> 2;
        bf16_t* base; int pitch = 1024; size_t row0; int col0 = (pn & 3) * 256; int mode = 0;
        const size_t rowL = (size_t)b * SEQ + tb, rowA = (size_t)b * LALL + (lat ? CTXL : 0) + tb;
        float qs = 1.0f;
        if (seg == 0) { base = Q; row0 = rowL; mode = 1; qs = 0.125f * 1.4426950408889634f; }
        else if (seg == 1) { base = KA; row0 = rowA; mode = lat ? 1 : 0; }
        else if (seg == 2) { base = VA; row0 = rowA; }
        else if (seg == 3) { base = GA; row0 = rowL; mode = 2; }
        else if (seg == 4) { base = XR; row0 = rowA; }
        else if (seg == 5) { base = GR; row0 = rowL; mode = 2; }
        else { base = GM; pitch = 2048; row0 = rowL; col0 = (pn - 24) * 256; mode = 3; }
        const int lcol = wc * 32 + 8 * fq;
        const float sgn = (fq & 2) ? 1.0f : -1.0f;
#pragma unroll
        for (int ai = 0; ai < 2; ++ai)
#pragma unroll
            for (int m = 0; m < 4; ++m) {
                const int rloc = ai * 128 + wr * 64 + m * 16 + fr;
                bf16_t* rowp = base + (row0 + rloc) * (size_t)pitch + col0 + lcol;
                const int pos = (wc & 1) ? (m * 16 + fr) : ((tb >> 6) + 2 * ai + wr);
                const f32x4* rp = (const f32x4*)(rope + pos * 16 + 8 * (fq & 1));
#pragma unroll
                for (int bj = 0; bj < 2; ++bj) {
                    f32x4 v[2] = {acc[ai][bj][m][0], acc[ai][bj][m][1]};
                    if (mode == 1) {
#pragma unroll
                        for (int n = 0; n < 2; ++n) {
                            f32x4 p;
#pragma unroll
                            for (int i = 0; i < 4; ++i) p[i] = __shfl_xor(v[n][i], 32);
                            const f32x4 c0 = rp[2 * n], c1 = rp[2 * n + 1];
                            v[n][0] = (v[n][0] * c0[0] + sgn * p[0] * c0[1]) * qs;
                            v[n][1] = (v[n][1] * c0[2] + sgn * p[1] * c0[3]) * qs;
                            v[n][2] = (v[n][2] * c1[0] + sgn * p[2] * c1[1]) * qs;
                            v[n][3] = (v[n][3] * c1[2] + sgn * p[3] * c1[3]) * qs;
                            asm volatile("" ::: "memory");
                        }
                    } else if (mode == 2) {
#pragma unroll
                        for (int n = 0; n < 2; ++n)
#pragma unroll
                            for (int i = 0; i < 4; ++i) v[n][i] = siluf_(v[n][i]);
                    } else if (mode == 3) {
#pragma unroll
                        for (int n = 0; n < 2; ++n)
#pragma unroll
                            for (int i = 0; i < 4; ++i) v[n][i] = sigmoidf_(v[n][i]);
                    }
                    u32x4 w; w.x = pk_bf16(v[0][0], v[0][1]); w.y = pk_bf16(v[0][2], v[0][3]); w.z = pk_bf16(v[1][0], v[1][1]); w.w = pk_bf16(v[1][2], v[1][3]);
                    *(u32x4*)(rowp + bj * 128) = w;
                }
                asm volatile("" ::: "memory");
            }
    }
};

struct PairOrder {
    pg8::StaticOrder S;
    __device__ void init(int G_, int c_) { S.init(ML, 1024, G_, c_); }
    __device__ bool next(int i, pg8::Unit& u) const { if (!S.next(i >> 1, u)) return false; if (i & 1) { u.pm += 128; u.pn += 4; } return true; }
    __device__ __forceinline__ void a_ready(const pg8::Unit&) const {}
    __device__ __forceinline__ void done(const pg8::Unit&) const {}
};
struct EpiMerge {
    static constexpr bool PERM = true, AFTER_DRAIN = false;
    const bf16_t* GM; bf16_t* MB;
    __device__ __forceinline__ bool chain(const pg8::Unit& u) const { return u.pm < 128; }
    __device__ __forceinline__ void operator()(f32x4 (&acc)[2][2][4][2], const pg8::Unit& u, int wr, int wc, int fr, int fq) const {
        const bool first = u.pm < 128;
        const int pm = first ? u.pm : u.pm - 128, pn = first ? u.pn : u.pn - 4;
#pragma unroll
        for (int ai = 0; ai < 2; ++ai)
#pragma unroll
            for (int m = 0; m < 4; ++m) {
                const size_t row = (size_t)pm * 256 + ai * 128 + wr * 64 + m * 16 + fr;
#pragma unroll
                for (int bj = 0; bj < 2; ++bj) {
                    const int col = pn * 256 + bj * 128 + wc * 32 + 8 * fq;
                    const u32x4 gl = *(const u32x4*)(GM + row * 2048 + 1024 + col);
                    float ml[8] = {bf_lo(gl.x), bf_hi(gl.x), bf_lo(gl.y), bf_hi(gl.y), bf_lo(gl.z), bf_hi(gl.z), bf_lo(gl.w), bf_hi(gl.w)};
                    if (first) {
                        const u32x4 ga = *(const u32x4*)(GM + row * 2048 + col);
                        const float ma[8] = {bf_lo(ga.x), bf_hi(ga.x), bf_lo(ga.y), bf_hi(ga.y), bf_lo(ga.z), bf_hi(ga.z), bf_lo(ga.w), bf_hi(ga.w)};
#pragma unroll
                        for (int i = 0; i < 4; ++i) { acc[ai][bj][m][0][i] *= ma[i] * __builtin_amdgcn_rcpf(fmaxf(ml[i], 1e-30f)); acc[ai][bj][m][1][i] *= ma[4 + i] * __builtin_amdgcn_rcpf(fmaxf(ml[4 + i], 1e-30f)); }
                    } else {
                        const f32x4 a0 = acc[ai][bj][m][0], a1 = acc[ai][bj][m][1];
                        u32x4 w; w.x = pk_bf16(a0[0] * ml[0], a0[1] * ml[1]); w.y = pk_bf16(a0[2] * ml[2], a0[3] * ml[3]); w.z = pk_bf16(a1[0] * ml[4], a1[1] * ml[5]); w.w = pk_bf16(a1[2] * ml[6], a1[3] * ml[7]);
                        *(u32x4*)(MB + row * 1024 + col) = w;
                    }
                }
                asm volatile("" ::: "memory");
            }
    }
};
struct EpiOut {
    static constexpr bool PERM = true, AFTER_DRAIN = false;
    __device__ __forceinline__ bool chain(const pg8::Unit&) const { return false; }
    bf16_t* Y; float* PART;
    __device__ __forceinline__ void operator()(const f32x4 (&acc)[2][2][4][2], const pg8::Unit& u, int wr, int wc, int fr, int fq) const {
#pragma unroll
        for (int ai = 0; ai < 2; ++ai)
#pragma unroll
            for (int m = 0; m < 4; ++m) {
                const size_t row = (size_t)u.pm * 256 + ai * 128 + wr * 64 + m * 16 + fr;
                float ss = 0.f;
#pragma unroll
                for (int bj = 0; bj < 2; ++bj) {
                    const int col = u.pn * 256 + bj * 128 + wc * 32 + 8 * fq;
                    const f32x4 a0 = acc[ai][bj][m][0], a1 = acc[ai][bj][m][1];
                    u32x4 w; w.x = pk_bf16(a0[0], a0[1]); w.y = pk_bf16(a0[2], a0[3]); w.z = pk_bf16(a1[0], a1[1]); w.w = pk_bf16(a1[2], a1[3]);
                    *(u32x4*)(Y + row * 1024 + col) = w;
                    ss += (a0[0] * a0[0] + a0[1] * a0[1]) + (a0[2] * a0[2] + a0[3] * a0[3]) + (a1[0] * a1[0] + a1[1] * a1[1]) + (a1[2] * a1[2] + a1[3] * a1[3]);
                }
                ss += __shfl_xor(ss, 16); ss += __shfl_xor(ss, 32);
                if (fq == 0) PART[row * 16 + u.pn * 4 + wc] = ss;
            }
    }
};

struct Params {
    const float *x, *c, *ctx, *c_ctx, *w_mod, *b_mod, *g_pre, *g_post, *w_in, *lq1, *lk1, *lq2, *lk2, *g_subln, *w_attn_out, *conv_w, *conv_b,
                *w_rg_a, *b_rg_a, *w_rg_x, *b_rg_x, *lru_lambda, *w_lru_out, *w_out;
    float* out; unsigned char* ws;
};

typedef const __attribute__((address_space(4))) Params* KP;

__device__ __forceinline__ float wave_sum(float v) {
#pragma unroll
    for (int o = 1; o < 64; o <<= 1) v += __shfl_xor(v, o);
    return v;
}

__device__ __forceinline__ void transpose_item(const float* W, int K, int N, bf16_t* WT, LAS float* scr, int item, int lane) {
    const int nblk = N / 32, kb = item / nblk, nb = item % nblk, k0 = 64 * kb, n0 = 32 * nb;
#pragma unroll 8
    for (int i = 0; i < 32; ++i) { const int kk = 2 * i + (lane >> 5); scr[kk * 33 + (lane & 31)] = W[(size_t)(k0 + kk) * N + n0 + (lane & 31)]; }
    asm volatile("s_waitcnt lgkmcnt(0)" ::: "memory");
    const int c = lane & 7;
#pragma unroll
    for (int j = 0; j < 4; ++j) { const int n = (lane >> 3) + 8 * j; const LAS float* s = scr + (8 * c) * 33 + n;
        u32x4 o; o.x = pk_bf16(s[0 * 33], s[1 * 33]); o.y = pk_bf16(s[2 * 33], s[3 * 33]); o.z = pk_bf16(s[4 * 33], s[5 * 33]); o.w = pk_bf16(s[6 * 33], s[7 * 33]);
        *(u32x4*)(WT + (size_t)(n0 + n) * K + k0 + 8 * c) = o; }
    asm volatile("s_waitcnt lgkmcnt(0)" ::: "memory");
}

__device__ __forceinline__ void phase0a(KP P, unsigned char* lds, int tid, int wid, int lane) {
    unsigned char* ws = P->ws;
    const int G = gridDim.x, bx = blockIdx.x;
    for (int item = bx; item < 192; item += G) {
        float* s = (float*)lds;
        float* red = (float*)(lds + 17 * 1024 * 4);
        for (int idx = tid; idx < 17 * 1024; idx += 512) { const int bb = idx >> 10, k = idx & 1023; const float v = bb < 16 ? P->c[bb * 1024 + k] : P->c_ctx[k]; s[idx] = siluf_(v); }
        __syncthreads();
        const int col = lane & 15, ksub = lane >> 4, n = item * 16 + col, k0 = wid * 128 + ksub * 32;
        float acc[17];
#pragma unroll
        for (int bb = 0; bb < 17; ++bb) acc[bb] = 0.f;
#pragma unroll 4
        for (int k = k0; k < k0 + 32; ++k) {
            const float w = P->w_mod[(size_t)k * 3072 + n];
#pragma unroll
            for (int bb = 0; bb < 17; ++bb) acc[bb] += s[bb * 1024 + k] * w;
        }
#pragma unroll
        for (int bb = 0; bb < 17; ++bb) red[((wid * 4 + ksub) * 17 + bb) * 16 + col] = acc[bb];
        __syncthreads();
        float* MODF = (float*)(ws + WS_MODF);
        for (int idx = tid; idx < 17 * 16; idx += 512) {
            const int bb = idx >> 4, l = idx & 15; float sum = 0.f;
#pragma unroll
            for (int w = 0; w < 32; ++w) sum += red[(w * 17 + bb) * 16 + l];
            MODF[bb * 3072 + item * 16 + l] = sum + P->b_mod[item * 16 + l];
        }
        __syncthreads();
    }
    if (bx == (200 % G)) {
        f32x2* rope = (f32x2*)(ws + WS_ROPE);
        for (int idx = tid; idx < 1024; idx += 512) {
            const int pos = idx >> 4, f = idx & 15;
            const float inv = powf(10000.0f, -(float)(2 * f) / 32.0f);
            const float ang = (float)pos * inv;
            rope[idx] = (f32x2){cosf(ang), sinf(ang)};
        }
    }
    LAS float* scr = (LAS float*)((LAS unsigned char*)lds + wid * 16384);
    const int gw = bx * 8 + wid, NGW = G * 8;
    constexpr int I_IN = 16 * 256, I_SQ = 16 * 32;
    for (int it = gw; it < I_IN + 3 * I_SQ; it += NGW) {
        int r = it;
        if (r < I_IN) { transpose_item(P->w_in, 1024, NIN, (bf16_t*)(ws + WS_WIN), scr, r, lane); continue; } r -= I_IN;
        if (r < I_SQ) { transpose_item(P->w_attn_out, 1024, 1024, (bf16_t*)(ws + WS_WA), scr, r, lane); continue; } r -= I_SQ;
        if (r < I_SQ) { transpose_item(P->w_lru_out, 1024, 1024, (bf16_t*)(ws + WS_WL), scr, r, lane); continue; } r -= I_SQ;
        transpose_item(P->w_out, 1024, 1024, (bf16_t*)(ws + WS_WO), scr, r, lane);
    }
}

__device__ __forceinline__ void phase0b(KP P, int wid, int lane) {
    const float* MODF = (const float*)(P->ws + WS_MODF);
    bf16_t* XN = (bf16_t*)(P->ws + WS_XN);
    const int gw = blockIdx.x * 8 + wid, NGW = gridDim.x * 8;
    const int per = (MALL + NGW - 1) / NGW;
    int r0 = gw * per, r1 = r0 + per; if (r1 > MALL) r1 = MALL;
    f32x4 g[4], sc[4], sh[4];
#pragma unroll
    for (int j = 0; j < 4; ++j) g[j] = *(const f32x4*)(P->g_pre + 4 * lane + 256 * j);
    int cur = -1;
    for (int row = r0; row < r1; ++row) {
        const int bb = row < ML ? (row >> 11) : 16;
        if (bb != cur) {
            cur = bb;
#pragma unroll
            for (int j = 0; j < 4; ++j) { sh[j] = *(const f32x4*)(MODF + bb * 3072 + 4 * lane + 256 * j); sc[j] = *(const f32x4*)(MODF + bb * 3072 + 1024 + 4 * lane + 256 * j);
                sc[j] = (sc[j] + 1.0f) * g[j]; }
        }
        const float* xr = row < ML ? P->x + (size_t)row * 1024 : P->ctx + (size_t)(row - ML) * 1024;
        f32x4 v[4]; float s = 0.f;
#pragma unroll
        for (int j = 0; j < 4; ++j) { v[j] = *(const f32x4*)(xr + 4 * lane + 256 * j); s += (v[j][0] * v[j][0] + v[j][1] * v[j][1]) + (v[j][2] * v[j][2] + v[j][3] * v[j][3]); }
        const float rstd = rsqrtf(wave_sum(s) * (1.0f / 1024.0f) + NORM_EPS);
#pragma unroll
        for (int j = 0; j < 4; ++j) {
            const f32x4 o = v[j] * rstd * sc[j] + sh[j];
            u32x2 w; w.x = pk_bf16(o[0], o[1]); w.y = pk_bf16(o[2], o[3]);
            *(u32x2*)(XN + (size_t)row * 1024 + 4 * lane + 256 * j) = w;
        }
    }
}

constexpr int LRU_DIRB = 59392;
constexpr int LRU_XCF = 0;
constexpr int LRU_XCB = 16384;
constexpr int LRU_SA = 16384 + 9216;
constexpr int LRU_SU = LRU_SA + 4 * 1040 * 4;
constexpr int LRU_CARRY = LRU_SU + 4 * 1040 * 4;
constexpr int LRU_CW = 2 * LRU_DIRB;
static_assert(LRU_CARRY + 256 <= LRU_DIRB && LRU_CW + 5 * 64 * 4 <= 131072, "lru lds");

__device__ __forceinline__ void lru_unit(KP P, unsigned char* lds_g, bf16_t* ZLOUT, int b, int nb, int tid, int wid, int lane) {
    unsigned char* ws = P->ws;
    LAS unsigned char* lds = (LAS unsigned char*)lds_g;
    const bf16_t* XR = (const bf16_t*)(ws + WS_XR) + (size_t)b * LALL * 1024 + nb * 64;
    bf16_t* HF = (bf16_t*)(ws + WS_XN) + (size_t)b * SEQ * 1024 + nb * 64;
    const bf16_t* GRZ = (const bf16_t*)(ws + WS_GR) + (size_t)b * SEQ * 1024 + nb * 64;
    bf16_t* ZL = ZLOUT + (size_t)b * SEQ * 1024 + nb * 64;
    const int tok = tid >> 3, cc = tid & 7;
    const unsigned aoff = tok * 1024 + cc * 8;
    if (tid < 320) { const int j = tid >> 6, ch = tid & 63; ((LAS float*)(lds + LRU_CW))[tid] = j < 4 ? P->conv_w[j * 1024 + nb * 64 + ch] : P->conv_b[nb * 64 + ch]; }
    const LAS float* cwl = (const LAS float*)(lds + LRU_CW) + cc * 8;
    const int wdir = wid >> 2, w4 = wid & 3;
    LAS unsigned char* ldsd = lds + wdir * LRU_DIRB;
    const int tt = w4 & 1, nh = w4 >> 1, hh = lane >> 5, jch = nh * 32 + (lane & 31), chB = nb * 64 + jch;
    const int sc_c = 16 * w4 + (lane & 15), sc_seg = lane >> 4;
    bf16x8 wA[4], wX[4];
    {
        const float* wa = P->w_rg_a + (size_t)(wdir * 16 + nb) * 4096 + jch;
        const float* wx = P->w_rg_x + (size_t)(wdir * 16 + nb) * 4096 + jch;
#pragma unroll
        for (int ks = 0; ks < 4; ++ks) {
            unsigned ua[4], ux[4];
#pragma unroll
            for (int j2 = 0; j2 < 4; ++j2) {
                const int i0 = 16 * ks + 8 * hh + 2 * j2;
                ua[j2] = pk_bf16(wa[i0 * 64], wa[(i0 + 1) * 64]);
                ux[j2] = pk_bf16(wx[i0 * 64], wx[(i0 + 1) * 64]);
            }
            wA[ks] = __builtin_bit_cast(bf16x8, (u32x4){ua[0], ua[1], ua[2], ua[3]});
            wX[ks] = __builtin_bit_cast(bf16x8, (u32x4){ux[0], ux[1], ux[2], ux[3]});
        }
    }
    const float ba2 = -1.4426950408889634f * P->b_rg_a[wdir * 1024 + chB], bx2 = -1.4426950408889634f * P->b_rg_x[wdir * 1024 + chB];
    const float sp8 = -8.0f * 1.4426950408889634f * log1pf(__expf(-P->lru_lambda[wdir * 1024 + chB]));
    if (tid < 64) { ((LAS float*)(lds + LRU_CARRY))[tid] = 0.f; ((LAS float*)(lds + LRU_DIRB + LRU_CARRY))[tid] = 0.f; }
    u32x4 xr[2][4];
#define LRU_LOAD_XR(IT) do { const int cf_ = (IT), cb_ = (IT) < 4 ? 3 - (IT) : 39 - (IT); \
        _Pragma("unroll") for (int d = 0; d < 2; ++d) { const int ci = d ? cb_ : cf_, lo = ci < 4 ? 0 : CTXL, hi = ci < 4 ? CTXL : LALL; \
            _Pragma("unroll") for (int j = 0; j < 4; ++j) { const int pp = ci * 64 + tok - 1 + j; xr[d][j] = (u32x4){0u, 0u, 0u, 0u}; \
                if (pp >= lo && pp < hi) xr[d][j] = *(const u32x4*)(XR + (ptrdiff_t)(ci * 64 - 1 + j) * 1024 + aoff); } } } while (0)
    LRU_LOAD_XR(0);
    __syncthreads();
#pragma unroll 1
    for (int it = 0; it < 36; ++it) {
        const int cf = it, cb = it < 4 ? 3 - it : 39 - it;
        {
            float xc[2][8];
            { const f32x4 c0 = *(const LAS f32x4*)(cwl + 256), c1 = *(const LAS f32x4*)(cwl + 260);
#pragma unroll
              for (int d = 0; d < 2; ++d) { xc[d][0] = c0[0]; xc[d][1] = c0[1]; xc[d][2] = c0[2]; xc[d][3] = c0[3]; xc[d][4] = c1[0]; xc[d][5] = c1[1]; xc[d][6] = c1[2]; xc[d][7] = c1[3]; } }
#pragma unroll
            for (int j = 0; j < 4; ++j) {
                const f32x4 w0 = *(const LAS f32x4*)(cwl + j * 64), w1 = *(const LAS f32x4*)(cwl + j * 64 + 4);
#pragma unroll
                for (int d = 0; d < 2; ++d) {
                    const u32x4 v = xr[d][j];
                    xc[d][0] += w0[0] * bf_lo(v.x); xc[d][1] += w0[1] * bf_hi(v.x); xc[d][2] += w0[2] * bf_lo(v.y); xc[d][3] += w0[3] * bf_hi(v.y);
                    xc[d][4] += w1[0] * bf_lo(v.z); xc[d][5] += w1[1] * bf_hi(v.z); xc[d][6] += w1[2] * bf_lo(v.w); xc[d][7] += w1[3] * bf_hi(v.w);
                }
            }
#pragma unroll
            for (int d = 0; d < 2; ++d) {
                LAS float* XCF = (LAS float*)(lds + d * LRU_DIRB + LRU_XCF);
                LAS unsigned char* XCB = lds + d * LRU_DIRB + LRU_XCB;
                *(LAS f32x4*)(XCF + tok * 64 + cc * 8) = (f32x4){xc[d][0], xc[d][1], xc[d][2], xc[d][3]};
                *(LAS f32x4*)(XCF + tok * 64 + cc * 8 + 4) = (f32x4){xc[d][4], xc[d][5], xc[d][6], xc[d][7]};
                u32x4 w; w.x = pk_bf16(xc[d][0], xc[d][1]); w.y = pk_bf16(xc[d][2], xc[d][3]); w.z = pk_bf16(xc[d][4], xc[d][5]); w.w = pk_bf16(xc[d][6], xc[d][7]);
                *(LAS u32x4*)(XCB + tok * 144 + cc * 16) = w;
            }
        }
        if (it + 1 < 36) LRU_LOAD_XR(it + 1);
        u32x4 stg[2], stf[2];
#pragma unroll
        for (int d = 0; d < 2; ++d) {
            const int ci = d ? cb : cf; const bool first = d ? (ci >= 20) : (ci <= 19);
            stg[d] = (u32x4){0u, 0u, 0u, 0u}; stf[d] = stg[d];
            if (ci >= 4 && !first) { const size_t off = (size_t)(ci * 64 - CTXL) * 1024 + aoff; stg[d] = *(const u32x4*)(GRZ + off); stf[d] = *(const u32x4*)(HF + off); }
        }
        LDS_BARRIER();
        {
            const LAS unsigned char* XCB = ldsd + LRU_XCB;
            f32x16 accA = {}, accX = {};
#pragma unroll
            for (int ks = 0; ks < 4; ++ks) {
                const bf16x8 af = *(const LAS bf16x8*)(XCB + (32 * tt + (lane & 31)) * 144 + (16 * ks + 8 * hh) * 2);
                accA = __builtin_amdgcn_mfma_f32_32x32x16_bf16(af, wA[ks], accA, 0, 0, 0);
                accX = __builtin_amdgcn_mfma_f32_32x32x16_bf16(af, wX[ks], accX, 0, 0, 0);
            }
            const int sbase = wdir == 0 ? (2 * tt * 1040 + 4 * hh * 64 + jch) : ((3 - 2 * tt) * 1040 + (15 - 4 * hh) * 64 + jch - 1744);
            const LAS float* xcf = (const LAS float*)(ldsd + LRU_XCF) + (32 * tt + 4 * hh) * 64 + jch;
            LAS float* SA = (LAS float*)(ldsd + LRU_SA) + sbase;
            LAS float* SU = (LAS float*)(ldsd + LRU_SU) + sbase;
            float av[16], uv[16];
#pragma unroll
            for (int r = 0; r < 16; ++r) {
                const float ra = __builtin_amdgcn_rcpf(1.0f + __builtin_amdgcn_exp2f(accA[r] * -1.4426950408889634f + ba2));
                const float ix = __builtin_amdgcn_rcpf(1.0f + __builtin_amdgcn_exp2f(accX[r] * -1.4426950408889634f + bx2));
                av[r] = __builtin_amdgcn_exp2f(sp8 * ra);
                uv[r] = __builtin_amdgcn_sqrtf(1.0f - av[r] * av[r]) * ix * xcf[(8 * (r >> 2) + (r & 3)) * 64];
            }
            if (wdir == 0) {
#pragma unroll
                for (int r = 0; r < 16; ++r) { const int cr = (r >> 3) * 1040 + (8 * ((r >> 2) & 1) + (r & 3)) * 64; SA[cr] = av[r]; SU[cr] = uv[r]; }
            } else {
#pragma unroll
                for (int r = 0; r < 16; ++r) { const int cr = (r >> 3) * 1040 + (8 * ((r >> 2) & 1) + (r & 3)) * 64; SA[1744 - cr] = av[r]; SU[1744 - cr] = uv[r]; }
            }
        }
        LDS_BARRIER();
        {
            LAS float* SA = (LAS float*)(ldsd + LRU_SA) + sc_seg * 1040 + sc_c;
            LAS float* SU = (LAS float*)(ldsd + LRU_SU) + sc_seg * 1040 + sc_c;
            LAS float* CARRY = (LAS float*)(ldsd + LRU_CARRY);
            float A = 1.f, U = 0.f;
#pragma unroll
            for (int s2 = 0; s2 < 16; ++s2) { const float a_ = SA[s2 * 64], u_ = SU[s2 * 64]; U = a_ * U + u_; A *= a_; }
#pragma unroll
            for (int d = 16; d < 64; d <<= 1) {
                const float Ap = __shfl_up(A, d), Up = __shfl_up(U, d);
                if (lane >= d) { U = A * Up + U; A = A * Ap; }
            }
            float Ae = __shfl_up(A, 16), Ue = __shfl_up(U, 16);
            if (sc_seg == 0) { Ae = 1.f; Ue = 0.f; }
            const float hc = CARRY[sc_c];
            float h = Ae * hc + Ue;
            if (sc_seg == 3) CARRY[sc_c] = A * hc + U;
#pragma unroll
            for (int s2 = 0; s2 < 16; ++s2) { h = SA[s2 * 64] * h + SU[s2 * 64]; SU[s2 * 64] = h; }
        }
        LDS_BARRIER();
#pragma unroll
        for (int d = 0; d < 2; ++d) {
            const int ci = d ? cb : cf;
            if (ci >= 4) {
                const int tau = d ? 63 - tok : tok;
                const LAS float* SU = (const LAS float*)(lds + d * LRU_DIRB + LRU_SU) + (tau >> 4) * 1040 + (tau & 15) * 64 + cc * 8;
                const f32x4 h0 = *(const LAS f32x4*)SU, h1 = *(const LAS f32x4*)(SU + 4);
                const size_t off = (size_t)(ci * 64 - CTXL) * 1024 + aoff;
                const bool first = d ? (ci >= 20) : (ci <= 19);
                if (first) {
                    u32x4 w; w.x = pk_bf16(h0[0], h0[1]); w.y = pk_bf16(h0[2], h0[3]); w.z = pk_bf16(h1[0], h1[1]); w.w = pk_bf16(h1[2], h1[3]);
                    *(u32x4*)(HF + off) = w;
                } else {
                    const u32x4 f = stf[d], g = stg[d];
                    u32x4 w;
                    w.x = pk_bf16((bf_lo(f.x) + h0[0]) * bf_lo(g.x), (bf_hi(f.x) + h0[1]) * bf_hi(g.x));
                    w.y = pk_bf16((bf_lo(f.y) + h0[2]) * bf_lo(g.y), (bf_hi(f.y) + h0[3]) * bf_hi(g.y));
                    w.z = pk_bf16((bf_lo(f.z) + h1[0]) * bf_lo(g.z), (bf_hi(f.z) + h1[1]) * bf_hi(g.z));
                    w.w = pk_bf16((bf_lo(f.w) + h1[2]) * bf_lo(g.w), (bf_hi(f.w) + h1[3]) * bf_hi(g.w));
                    *(u32x4*)(ZL + off) = w;
                }
            }
        }
    }
    __syncthreads();
}

constexpr int ATT_KSLOT = 8192, ATT_V0 = 3 * 8192, ATT_VBUF = 16384, ATT_STASH = ATT_V0 + 2 * ATT_VBUF;
__device__ __forceinline__ s16x4 vtr(const LAS unsigned char* p) { return __builtin_bit_cast(s16x4, __builtin_amdgcn_ds_read_tr16_b64_v4i16((LAS s16x4*)p)); }

__device__ __forceinline__ void attn_qk(const LAS unsigned char* lds, int kcur, const int (&kaddr)[4], const bf16x8 (&qf)[4], const f32x16& cinit, f32x16& p0, f32x16& p1) {
    p0 = cinit; p1 = cinit;
#pragma unroll
    for (int ks = 0; ks < 4; ++ks) {
        const bf16x8 k0 = *(const LAS bf16x8*)(lds + kcur + kaddr[ks]);
        const bf16x8 k1 = *(const LAS bf16x8*)(lds + kcur + kaddr[ks] + 4096);
        p0 = __builtin_amdgcn_mfma_f32_32x32x16_bf16(k0, qf[ks], p0, 0, 0, 0);
        p1 = __builtin_amdgcn_mfma_f32_32x32x16_bf16(k1, qf[ks], p1, 0, 0, 0);
    }
}
__device__ __forceinline__ void attn_tile(const LAS unsigned char* lds, int knext, int vcur, const int (&kaddr)[4], const int (&vaddr)[4], const bf16x8 (&qf)[4],
                                          f32x16& p0, f32x16& p1, f32x16& pn0, f32x16& pn1, f32x16 (&o)[4], float& m_ref, float& l, float& mx, f32x16& negm) {
    constexpr float THR = 8.0f;
    if (__builtin_amdgcn_ballot_w64(mx > m_ref + THR) != 0ull) {
        const float mf = fmaxf(mx, __shfl_xor(mx, 32));
        if (mf > m_ref + THR) {
            const float delta = mf - m_ref, alpha = __builtin_amdgcn_exp2f(-delta);
            l *= alpha;
#pragma unroll
            for (int d = 0; d < 4; ++d) o[d] = o[d] * alpha;
            p0 = p0 - delta; p1 = p1 - delta;
            m_ref = mf;
#pragma unroll
            for (int r = 0; r < 16; ++r) negm[r] = -mf;
        }
    }
    attn_qk(lds, knext, kaddr, qf, negm, pn0, pn1);
    unsigned pa[4][4];
    float ls = 0.f;
#pragma unroll
    for (int r = 0; r < 16; r += 2) {
        const float e0 = __builtin_amdgcn_exp2f(p0[r]), e1 = __builtin_amdgcn_exp2f(p0[r + 1]);
        const float f0 = __builtin_amdgcn_exp2f(p1[r]), f1 = __builtin_amdgcn_exp2f(p1[r + 1]);
        ls += (e0 + e1) + (f0 + f1);
        pa[r >> 3][(r & 7) >> 1] = pk_bf16(e0, e1);
        pa[2 + (r >> 3)][(r & 7) >> 1] = pk_bf16(f0, f1);
    }
    l += ls;
    {
        float mn = pn0[0];
#pragma unroll
        for (int r = 1; r < 16; ++r) mn = fmaxf(mn, pn0[r]);
#pragma unroll
        for (int r = 0; r < 16; ++r) mn = fmaxf(mn, pn1[r]);
        mx = mn + m_ref;
    }
    bf16x8 vf[2][4];
#define ATT_LDV(S, BUF) do { _Pragma("unroll") for (int dvt = 0; dvt < 4; ++dvt) { \
        const s16x4 lo = vtr(lds + vcur + vaddr[dvt] + (S) * 4096), hh2 = vtr(lds + vcur + vaddr[dvt] + (S) * 4096 + 2048); \
        vf[BUF][dvt] = (bf16x8){lo[0], lo[1], lo[2], lo[3], hh2[0], hh2[1], hh2[2], hh2[3]}; } } while (0)
    ATT_LDV(0, 0);
#pragma unroll
    for (int s = 0; s < 4; ++s) {
        if (s < 3) ATT_LDV(s + 1, (s + 1) & 1);
        const bf16x8 pb = __builtin_bit_cast(bf16x8, (u32x4){pa[s][0], pa[s][1], pa[s][2], pa[s][3]});
#pragma unroll
        for (int dvt = 0; dvt < 4; ++dvt) o[dvt] = __builtin_amdgcn_mfma_f32_32x32x16_bf16(vf[s & 1][dvt], pb, o[dvt], 0, 0, 0);
    }
#undef ATT_LDV
}

__device__ __forceinline__ void attn_unit(KP P, unsigned char* lds_g, bf16_t* ZOUT, int b, int h, int qb, float lam, int tid, int wid, int lane) {
    unsigned char* ws = P->ws;
    LAS unsigned char* lds = (LAS unsigned char*)lds_g;
    bf16_t* QZ = (bf16_t*)(ws + WS_Q);
    const bf16_t* KA = (const bf16_t*)(ws + WS_KA);
    const bf16_t* VA = (const bf16_t*)(ws + WS_VA);
    const bf16_t* GA = (const bf16_t*)(ws + WS_GA);
    const int q = lane & 31, hi = lane >> 5;
    const size_t qrow_u = ((size_t)b * SEQ + qb * 256 + wid * 32) * 1024 + h * 128;
    const unsigned qoff = q * 1024 + 8 * hi;
    constexpr float C2 = 0.125f * 1.4426950408889634f;
    constexpr float THR = 8.0f;
    unsigned koff; unsigned voff[2];
    { const int row = 8 * wid + (lane >> 3), pc = lane & 7; koff = row * 1024 + (pc ^ ((row >> 1) & 7)) * 8; }
#pragma unroll
    for (int i = 0; i < 2; ++i) { const int row = 4 * (2 * wid + i) + (lane >> 4), pc = lane & 15, c = (((pc >> 2) ^ (row & 3)) << 2) | (pc & 3); voff[i] = row * 1024 + c * 8; }
    const int kpiece = wid * 1024, vpiece = ATT_V0 + wid * 2048;
#define ATT_DMA(G, L) do { unsigned keep_; const void* g_ = (const void*)(G); const unsigned l_ = (unsigned)__builtin_amdgcn_readfirstlane((int)(unsigned)(uintptr_t)(L)); \
        asm volatile("s_mov_b32 %0, m0\n\ts_mov_b32 m0, %2\n\ts_nop 0\n\tglobal_load_lds_dwordx4 %1, off\n\ts_mov_b32 m0, %0" : "=&s"(keep_) : "v"(g_), "s"(l_) : "memory"); } while (0)
    int kaddr[4];
#pragma unroll
    for (int ks = 0; ks < 4; ++ks) kaddr[ks] = q * 128 + 16 * ((2 * ks + hi) ^ ((q >> 1) & 7));
    int vaddr[4];
    { const int g = lane >> 4, qq = (lane >> 2) & 3, pp = lane & 3, h2 = g >> 1;
#pragma unroll
      for (int dvt = 0; dvt < 4; ++dvt) vaddr[dvt] = ATT_V0 + (4 * h2 + qq) * 256 + ((dvt ^ qq) * 64) + (g & 1) * 32 + pp * 8; }

    LAS unsigned* o1s = (LAS unsigned*)(lds + ATT_STASH + wid * 8192) + lane;
    const bf16_t* Kb = KA + (size_t)b * LALL * 1024 + h * 128;
    const bf16_t* Vb = VA + (size_t)b * LALL * 1024 + h * 128;

#pragma unroll 1
    for (int pass = 0; pass < 2; ++pass) {
        bf16x8 qf[4];
#pragma unroll
        for (int ks = 0; ks < 4; ++ks) qf[ks] = *(const bf16x8*)(QZ + qrow_u + pass * 64 + 16 * ks + qoff);
        const bf16_t* Kp = Kb + pass * 64;
        f32x16 o[4];
#pragma unroll
        for (int d = 0; d < 4; ++d) o[d] = (f32x16){};
        float m_ref = -1e30f, l = 0.f;
        {
            ATT_DMA(Kp + koff, lds + kpiece); ATT_DMA(Kp + 65536 + koff, lds + ATT_KSLOT + kpiece);
            ATT_DMA(Vb + voff[0], lds + vpiece); ATT_DMA(Vb + voff[1], lds + vpiece + 1024);
            asm volatile("s_waitcnt vmcnt(0)" ::: "memory");
        }
        __syncthreads();
        asm volatile("" :: "v"(qf[0]), "v"(qf[1]), "v"(qf[2]), "v"(qf[3]));
        f32x16 pa0, pa1, pb0, pb1, negm = {};
        attn_qk(lds, 0, kaddr, qf, negm, pa0, pa1);
        float mxc = pa0[0];
#pragma unroll
        for (int r = 1; r < 16; ++r) mxc = fmaxf(mxc, pa0[r]);
#pragma unroll
        for (int r = 0; r < 16; ++r) mxc = fmaxf(mxc, pa1[r]);
        m_ref = fmaxf(mxc, __shfl_xor(mxc, 32));
        pa0 = pa0 - m_ref; pa1 = pa1 - m_ref;
#pragma unroll
        for (int r = 0; r < 16; ++r) negm[r] = -m_ref;
        int ks1 = ATT_KSLOT, ks2 = 2 * ATT_KSLOT;
#define ATT_STEP(T, PC0, PC1, PN0, PN1, VCUR, VNXT) do { \
            const size_t rk = (size_t)((T) + 2 < LALL / 64 ? (T) + 2 : LALL / 64 - 1) * 65536, rv = (size_t)((T) + 1 < LALL / 64 ? (T) + 1 : LALL / 64 - 1) * 65536; \
            ATT_DMA(Kp + rk + koff, lds + ks2 + kpiece); ATT_DMA(Vb + rv + voff[0], lds + (VNXT) + vpiece); ATT_DMA(Vb + rv + voff[1], lds + (VNXT) + vpiece + 1024); \
            attn_tile(lds, ks1, (VCUR), kaddr, vaddr, qf, PC0, PC1, PN0, PN1, o, m_ref, l, mxc, negm); \
            asm volatile("s_waitcnt vmcnt(0)" ::: "memory"); \
            { const int k3 = ks1 + ks2 == 3 * ATT_KSLOT ? 0 : (ks1 + ks2 == ATT_KSLOT ? 2 * ATT_KSLOT : ATT_KSLOT); ks1 = ks2; ks2 = k3; } \
            __syncthreads(); } while (0)
#pragma unroll 1
        for (int t = 0; t < LALL / 64; t += 2) {
            ATT_STEP(t, pa0, pa1, pb0, pb1, 0, ATT_VBUF);
            ATT_STEP(t + 1, pb0, pb1, pa0, pa1, ATT_VBUF, 0);
        }
#undef ATT_STEP
        const float lt = l + __shfl_xor(l, 32);
        const float inv = 1.0f / lt;
        if (pass == 0) {
#pragma unroll
            for (int d = 0; d < 4; ++d)
#pragma unroll
                for (int r = 0; r < 16; r += 2) o1s[(d * 8 + (r >> 1)) * 64] = pk_bf16(o[d][r] * inv, o[d][r + 1] * inv);
        } else {
            const float li = lam * inv;
            float ss = 0.f;
#pragma unroll
            for (int d = 0; d < 4; ++d) {
#pragma unroll
                for (int r = 0; r < 16; r += 2) {
                    const unsigned o1 = o1s[(d * 8 + (r >> 1)) * 64];
                    const float a0 = bf_lo(o1) - li * o[d][r], a1 = bf_hi(o1) - li * o[d][r + 1];
                    ss += a0 * a0 + a1 * a1;
                }
                asm volatile("" ::: "memory");
            }
            ss += __shfl_xor(ss, 32);
            const float rstd = rsqrtf(ss * (1.0f / 128.0f) + NORM_EPS) * (1.0f - LAM_INIT);
            const unsigned eoff = q * 1024 + 8 * hi;
#pragma unroll
            for (int d = 0; d < 4; ++d)
#pragma unroll
                for (int pr = 0; pr < 2; ++pr) {
                    float va[4], vb[4];
#pragma unroll
                    for (int i = 0; i < 4; i += 2) {
                        const unsigned oa = o1s[(d * 8 + 4 * pr + (i >> 1)) * 64], ob = o1s[(d * 8 + 4 * pr + 2 + (i >> 1)) * 64];
                        va[i] = bf_lo(oa) - li * o[d][8 * pr + i]; va[i + 1] = bf_hi(oa) - li * o[d][8 * pr + i + 1];
                        vb[i] = bf_lo(ob) - li * o[d][8 * pr + 4 + i]; vb[i + 1] = bf_hi(ob) - li * o[d][8 * pr + 4 + i + 1];
                    }
#pragma unroll
                    for (int i = 0; i < 4; ++i) {
                        auto rr = __builtin_amdgcn_permlane32_swap(__float_as_uint(va[i]), __float_as_uint(vb[i]), false, false);
                        va[i] = __uint_as_float(rr[0]); vb[i] = __uint_as_float(rr[1]);
                    }
                    const int dv0 = 32 * d + 16 * pr + 8 * hi;
                    const f32x4 gs0 = *(const f32x4*)(P->g_subln + dv0), gs1 = *(const f32x4*)(P->g_subln + dv0 + 4);
                    const u32x4 ga = *(const u32x4*)(GA + qrow_u + 32 * d + 16 * pr + eoff);
                    u32x4 w;
                    w.x = pk_bf16(va[0] * rstd * gs0[0] * bf_lo(ga.x), va[1] * rstd * gs0[1] * bf_hi(ga.x));
                    w.y = pk_bf16(va[2] * rstd * gs0[2] * bf_lo(ga.y), va[3] * rstd * gs0[3] * bf_hi(ga.y));
                    w.z = pk_bf16(vb[0] * rstd * gs1[0] * bf_lo(ga.z), vb[1] * rstd * gs1[1] * bf_hi(ga.z));
                    w.w = pk_bf16(vb[2] * rstd * gs1[2] * bf_lo(ga.w), vb[3] * rstd * gs1[3] * bf_hi(ga.w));
                    *(u32x4*)(ZOUT + qrow_u + 32 * d + 16 * pr + eoff) = w;
                    asm volatile("" ::: "memory");
                }
        }
    }
}

__device__ __forceinline__ void phase4(KP P, int wid, int lane) {
    const float* MODF = (const float*)(P->ws + WS_MODF);
    const bf16_t* Y = (const bf16_t*)(P->ws + WS_T);
    const float* PART = (const float*)(P->ws + WS_PART);
    const int gw = blockIdx.x * 8 + wid, NGW = gridDim.x * 8;
    f32x4 gp[4];
#pragma unroll
    for (int j = 0; j < 4; ++j) gp[j] = *(const f32x4*)(P->g_post + 4 * lane + 256 * j);
    for (int row = gw; row < ML; row += NGW) {
        const int b = row >> 11;
        float ss = PART[(size_t)row * 16 + (lane & 15)];
        ss += __shfl_xor(ss, 1); ss += __shfl_xor(ss, 2); ss += __shfl_xor(ss, 4); ss += __shfl_xor(ss, 8);
        const float rstd = rsqrtf(ss * (1.0f / 1024.0f) + NORM_EPS);
#pragma unroll
        for (int j = 0; j < 4; ++j) {
            const int c = 4 * lane + 256 * j;
            const f32x4 xv = *(const f32x4*)(P->x + (size_t)row * 1024 + c);
            const u32x2 yb = *(const u32x2*)(Y + (size_t)row * 1024 + c);
            const f32x4 yv = (f32x4){bf_lo(yb.x), bf_hi(yb.x), bf_lo(yb.y), bf_hi(yb.y)};
            const f32x4 gt = *(const f32x4*)(MODF + b * 3072 + 2048 + c);
            *(f32x4*)(P->out + (size_t)row * 1024 + c) = xv + gt * (yv * rstd * gp[j]);
        }
    }
}

#define XB_TMO      128
#define XB_XCNT(j)  (256  + 64 * (j))
#define XB_XSUB(j)  (1280 + 64 * (j))
#define XB_XGEN(j)  (2304 + 64 * (j))
#define XB_TOP      3328
#define XB_TOPGEN   3392
#define XCD_BAR_WORDS 3456
#define XB_SPIN_CAP (1u << 18)

__device__ __forceinline__ unsigned xb_ld(unsigned* p)              { return __hip_atomic_load(p, __ATOMIC_RELAXED, __HIP_MEMORY_SCOPE_AGENT); }
__device__ __forceinline__ unsigned xb_add(unsigned* p, unsigned v) { return __hip_atomic_fetch_add(p, v, __ATOMIC_RELAXED, __HIP_MEMORY_SCOPE_AGENT); }
__device__ __forceinline__ unsigned xb_xcc_id() { return (unsigned)__builtin_amdgcn_s_getreg((3 << 11) | 20) & 0xFu; }
#define XB_SPIN(cond, bar) do { unsigned _sp = 0; while (cond) { __builtin_amdgcn_s_sleep(1); \
    if ((++_sp & 255u) == 0u) { if (xb_ld(&(bar)[XB_TMO])) break; if (_sp > XB_SPIN_CAP) { atomicAdd(&(bar)[XB_TMO], 1u); break; } } } } while (0)

struct XcdBarrier {
    unsigned* bar; unsigned x;
    volatile LAS unsigned* st;
};

__device__ __forceinline__ XcdBarrier xcd_barrier_post(unsigned* bar, volatile LAS unsigned* st) {
    XcdBarrier b; b.bar = bar; b.x = xb_xcc_id(); b.st = st;
    if (threadIdx.x == 0) (void)xb_add(&bar[XB_XCNT(b.x)], 1u);
    return b;
}
__device__ __forceinline__ void xcd_barrier_complete(unsigned* bar, unsigned x, unsigned& nloc, unsigned& nx) {
    const unsigned G = gridDim.x * gridDim.y * gridDim.z;
    unsigned sum, cnt, mine, sp = 0u;
    for (;;) {
        sum = 0u; cnt = 0u; mine = 0u;
#pragma unroll
        for (unsigned j = 0; j < 16; ++j) { const unsigned c = xb_ld(&bar[XB_XCNT(j)]); sum += c; cnt += (c > 0u) ? 1u : 0u; mine = (j == x) ? c : mine; }
        if (sum == G) break;
        __builtin_amdgcn_s_sleep(1);
        if ((++sp & 255u) == 0u) { if (xb_ld(&bar[XB_TMO])) break; if (sp > XB_SPIN_CAP) { atomicAdd(&bar[XB_TMO], 1u); break; } }
    }
    nloc = mine > 0u ? mine : 1u; nx = cnt > 0u ? cnt : 1u;
}

__device__ __forceinline__ void xcd_barrier(const XcdBarrier& b) {
    asm volatile("s_waitcnt vmcnt(0)" ::: "memory");
    __syncthreads();
    if (threadIdx.x == 0) {
        unsigned* bar = b.bar;
        __builtin_amdgcn_s_waitcnt(0);
        unsigned nloc = b.st[0], nx = b.st[1];
        if (nloc == 0u) { xcd_barrier_complete(bar, b.x, nloc, nx); b.st[0] = nloc; b.st[1] = nx; }
        const unsigned old = xb_add(&bar[XB_XSUB(b.x)], 1u);
        const unsigned gen = old / nloc;
        if (old + 1u == (gen + 1u) * nloc) {
            __builtin_amdgcn_fence(__ATOMIC_RELEASE, "agent");
            asm volatile("s_waitcnt vmcnt(0)" ::: "memory");
            const unsigned og = xb_add(&bar[XB_TOP], 1u);
            const unsigned tg = og / nx;
            if (og + 1u == (tg + 1u) * nx) xb_add(&bar[XB_TOPGEN], 1u);
            else XB_SPIN(xb_ld(&bar[XB_TOPGEN]) == tg, bar);
            __builtin_amdgcn_fence(__ATOMIC_ACQUIRE, "agent");
            xb_add(&bar[XB_XGEN(b.x)], 1u);
            asm volatile("s_waitcnt vmcnt(0)" ::: "memory");
        } else {
            XB_SPIN(xb_ld(&bar[XB_XGEN(b.x)]) == gen, bar);
            __builtin_amdgcn_fence(__ATOMIC_ACQUIRE, "agent");
            asm volatile("s_waitcnt vmcnt(0)" ::: "memory");
        }
    }
    __syncthreads();
}

__global__ void __launch_bounds__(512, 2) hybrid_fwd(Params Pval) {
    KP P = (KP)__builtin_amdgcn_kernarg_segment_ptr();
    extern __shared__ __attribute__((aligned(16))) unsigned char lds[];
    cg::grid_group grid = cg::this_grid();
#define FRESH_TID() int tid = threadIdx.x; asm volatile("" : "+v"(tid)); const int lane = tid & 63, wid = __builtin_amdgcn_readfirstlane(tid >> 6)
    const int G = gridDim.x, bx = blockIdx.x;
    unsigned char* ws = P->ws;
    if (threadIdx.x < 2) ((volatile LAS unsigned*)((LAS unsigned char*)lds + LDS_BARW))[threadIdx.x] = 0u;
    __syncthreads();
    const XcdBarrier xbar = xcd_barrier_post((unsigned*)(ws + WS_BAR), (volatile LAS unsigned*)((LAS unsigned char*)lds + LDS_BARW));
    LAS unsigned char* ldsl = (LAS unsigned char*)lds;

#ifndef NO_P0A
    { FRESH_TID(); phase0a(P, lds, tid, wid, lane); }
#endif
    grid.sync();
#ifndef NO_P0B
    { FRESH_TID(); (void)tid; phase0b(P, wid, lane); }
#endif
    xcd_barrier(xbar);
#ifndef NO_P1
    {
        pg8::Gemm g{(const bf16_t*)(ws + WS_XN), (const bf16_t*)(ws + WS_WIN), MALL, NIN, 1024};
        InProjOrder S; S.init(G, bx);
        EpiInProj E{(bf16_t*)(ws + WS_Q), (bf16_t*)(ws + WS_KA), (bf16_t*)(ws + WS_VA), (bf16_t*)(ws + WS_GA), (bf16_t*)(ws + WS_XR), (bf16_t*)(ws + WS_GR), (bf16_t*)P->out,
                    (const f32x2*)(ws + WS_ROPE)};
        pg8::gemm_phase<EpiInProj, InProjOrder, true, true>(ldsl, g, S, E);
    }
#endif
    xcd_barrier(xbar);
    {
        const int vcu = (G % 8 == 0) ? (bx % 8) * (G / 8) + bx / 8 : bx;
#ifndef NO_LRU
        { FRESH_TID(); for (int u = vcu; u < 256; u += G) lru_unit(P, lds, (bf16_t*)(ws + WS_GR), u >> 4, u & 15, tid, wid, lane); }
#endif
#ifndef NO_ATT
        { FRESH_TID();
          float s1 = P->lq1[lane] * P->lk1[lane], s2 = P->lq2[lane] * P->lk2[lane];
          s1 = wave_sum(s1); s2 = wave_sum(s2);
          const float lam = __expf(s1) - __expf(s2) + LAM_INIT;
          for (int u = vcu; u < 1024; u += G) { const int bh = u >> 3; attn_unit(P, lds, (bf16_t*)(ws + WS_Q), bh >> 3, bh & 7, u & 7, lam, tid, wid, lane); } }
#endif
    }
    xcd_barrier(xbar);
#ifndef NO_P3A
    {
        PairOrder S; S.init(G, bx);
        pg8::Gemm g{(const bf16_t*)(ws + WS_Q), (const bf16_t*)(ws + WS_WA), 2 * ML, 2048, 1024};
        static_assert(WS_GR - WS_Q == (size_t)ML * 1024 * 2 && WS_WL - WS_WA == (size_t)1024 * 1024 * 2, "the second merge GEMM's operands must sit one full matrix behind the first's");
        EpiMerge E{(const bf16_t*)P->out, (bf16_t*)(ws + WS_XN)};
        pg8::gemm_phase<EpiMerge, PairOrder, true, true>(ldsl, g, S, E);
    }
#endif
    xcd_barrier(xbar);
#ifndef NO_P3B
    {
        pg8::StaticOrder S; S.init(ML, 1024, G, bx);
        pg8::Gemm g{(const bf16_t*)(ws + WS_XN), (const bf16_t*)(ws + WS_WO), ML, 1024, 1024};
        EpiOut E{(bf16_t*)(ws + WS_T), (float*)(ws + WS_PART)};
        pg8::gemm_phase<EpiOut, pg8::StaticOrder, true, true>(ldsl, g, S, E);
    }
#endif
    xcd_barrier(xbar);
#ifndef NO_P4
    { FRESH_TID(); (void)tid; phase4(P, wid, lane); }
#endif
}

extern "C" void kernel_launch(void* const* d_in, const int* in_sizes, int n_in, void* d_out, int out_size, void* d_ws, size_t ws_size, hipStream_t stream) {
    static int grid_blocks = 0;
    if (grid_blocks == 0) {
        if (n_in != 24 || out_size != ML * DM || ws_size < WS_END) { fprintf(stderr, "kernel_launch: unexpected problem (n_in %d out %d ws %zu)\n", n_in, out_size, ws_size); grid_blocks = -1; return; }
        int dev = 0, cus = 0, per_cu = 0;
        hipGetDevice(&dev);
        hipDeviceGetAttribute(&cus, hipDeviceAttributeMultiprocessorCount, dev);
        if (hipFuncSetAttribute((const void*)hybrid_fwd, hipFuncAttributeMaxDynamicSharedMemorySize, LDS_BYTES) != hipSuccess) { fprintf(stderr, "kernel_launch: hipFuncSetAttribute failed\n"); grid_blocks = -1; return; }
        if (hipOccupancyMaxActiveBlocksPerMultiprocessor(&per_cu, (const void*)hybrid_fwd, 512, LDS_BYTES) != hipSuccess || per_cu < 1) { fprintf(stderr, "kernel_launch: occupancy query failed (%d)\n", per_cu); (void)hipGetLastError(); per_cu = 1; }
        grid_blocks = cus;
        fprintf(stderr, "kernel_launch: cus %d per_cu %d grid %d\n", cus, per_cu, grid_blocks);
    }
    if (grid_blocks < 0) return;
    Params p{};
    const float** pf = (const float**)&p;
    for (int i = 0; i < 24; ++i) pf[i] = (const float*)d_in[i];
    p.out = (float*)d_out; p.ws = (unsigned char*)d_ws;
    if (hipMemsetAsync((char*)d_ws + WS_BAR, 0, WS_BAR_BYTES, stream) != hipSuccess) { fprintf(stderr, "kernel_launch: memset of the barrier words failed\n"); return; }
    void* args[] = {&p};
    hipError_t e = hipLaunchCooperativeKernel((const void*)hybrid_fwd, dim3(grid_blocks), dim3(512), args, LDS_BYTES, stream);
    if (e != hipSuccess) fprintf(stderr, "kernel_launch: cooperative launch failed: %s (grid %d)\n", hipGetErrorString(e), grid_blocks);
}
```

```cpp
#include <hip/hip_runtime.h>
#include <hip/hip_cooperative_groups.h>
#include <cstdio>
#include <cstdint>
namespace cg = cooperative_groups;
namespace pg8 {
#define PG8_LAS __attribute__((address_space(3)))
typedef unsigned short bf16_t;
typedef short bf16x8 __attribute__((ext_vector_type(8)));
typedef float f32x4 __attribute__((ext_vector_type(4)));
typedef unsigned u32x4 __attribute__((ext_vector_type(4)));
constexpr int BM = 256, BK = 64, HALF = 128, HTB = HALF * BK * 2  , STAGE_BYTES = 8 * HTB, NXCD = 8, WGM = 8;

__host__ __device__ __forceinline__ int lds_byte(int r, int c) { const int st = (r >> 4) * 2 + (c >> 5), rr = r & 15, cc = c & 31, ob = rr * 64 + cc * 2; return st * 1024 + (ob ^ (((ob >> 9) & 1) << 5)); }
__host__ __device__ __forceinline__ void stage_rc(int b, int& R, int& C) { const int st = b / 1024, sb = b % 1024, swz = sb ^ (((sb >> 9) & 1) << 5); R = (st >> 1) * 16 + swz / 64; C = (st & 1) * 32 + (swz % 64) / 2; }
__host__ __device__ __forceinline__ int perm32(int rho) { const int n = rho >> 4, i = rho & 15; return 8 * (i >> 2) + 4 * n + (i & 3); }

struct Unit { int pm, pn; };
struct Gemm { const bf16_t* A; const bf16_t* Bt; int M, N, K; };

struct StaticOrder {
    int nM, nN, nwg, G, c;
    __host__ __device__ void init(int M, int N, int G_, int c_) { nM = M / BM; nN = N / BM; nwg = nM * nN; G = G_; c = c_; }
    __host__ __device__ bool next(int i, Unit& u) const {
        const long L = (long)i * G + c; if (L >= nwg) return false;
        int wgid = (int)L; { const int q = nwg / NXCD, r = nwg % NXCD, xcd = wgid % NXCD, off = wgid / NXCD; wgid = (xcd < r ? xcd * (q + 1) : r * (q + 1) + (xcd - r) * q) + off; }
        const int nig = WGM * nN, gid = wgid / nig, fm = gid * WGM, gsz = (nM - fm) < WGM ? (nM - fm) : WGM;
        u.pm = fm + ((wgid % nig) % gsz); u.pn = (wgid % nig) / gsz; return true;
    }
    __device__ __forceinline__ void a_ready(const Unit&) const {}
    __device__ __forceinline__ void done(const Unit&) const {}
};

__device__ __forceinline__ unsigned cvt_pk_bf16(float lo, float hi) { unsigned r; asm volatile("v_cvt_pk_bf16_f32 %0, %1, %2" : "=v"(r) : "v"(lo), "v"(hi)); return r; }
typedef float f32x2 __attribute__((ext_vector_type(2)));
template <class Epi, class Sched, bool ALIGN_EPI = false, bool SP2 = false>
__device__ __forceinline__ void gemm_phase(PG8_LAS unsigned char* lds, const Gemm g, const Sched& S, const Epi& E) {
    int tid_ = threadIdx.x; asm volatile("" : "+v"(tid_));
    const int tid = tid_, wid = __builtin_amdgcn_readfirstlane(tid >> 6), lane = tid & 63, wr = wid >> 2, wc = wid & 3, fr = lane & 15, fq = lane >> 4;
    const int K = g.K, nt = K / BK;
    unsigned voffA[2], voffB[2];
#pragma unroll
    for (int i = 0; i < 2; ++i) { int R, C; stage_rc(tid * 16 + i * 8192, R, C); const int Rb = Epi::PERM ? ((R & ~31) + perm32(R & 31)) : R;
        voffA[i] = (unsigned)(R * K + C) * 2u; voffB[i] = (unsigned)(Rb * K + C) * 2u; }
    const size_t kstep = (size_t)(BK * 2);
    const size_t hstep = (size_t)HALF * K * 2;
    const size_t tstep = 2 * hstep;
    const unsigned ldsw = (unsigned)wid * 1024u;
    const int aoff = lds_byte(wr * 64 + fr, fq * 8), boff = lds_byte(wc * 32 + fr, fq * 8);
#define PG8_SA(b, h) (((b) * 2 + (h)) * HTB)
#define PG8_SB(b, h) ((4 + (b) * 2 + (h)) * HTB)
#define PG8_STAGE(bufoff, gbase, voff) do { _Pragma("unroll") for (int _i = 0; _i < 2; ++_i) \
        __builtin_amdgcn_global_load_lds((const unsigned*)((const char*)(gbase) + (voff)[_i]), (PG8_LAS unsigned*)(lds + (bufoff) + ldsw + _i * 8192), 16, 0, 0); } while (0)
#define PG8_LDA(dst, b, h) do { _Pragma("unroll") for (int m = 0; m < 4; ++m) _Pragma("unroll") for (int k = 0; k < 2; ++k) dst[m][k] = *(const PG8_LAS bf16x8*)(lds + PG8_SA(b, h) + aoff + m * 2048 + k * 1024); } while (0)
#define PG8_LDB(dst, b, h) do { _Pragma("unroll") for (int n = 0; n < 2; ++n) _Pragma("unroll") for (int k = 0; k < 2; ++k) dst[n][k] = *(const PG8_LAS bf16x8*)(lds + PG8_SB(b, h) + boff + n * 2048 + k * 1024); } while (0)
#define PG8_MMA(ai, bj, At, Bt) do { __builtin_amdgcn_s_setprio(1); _Pragma("unroll") for (int m = 0; m < 4; ++m) _Pragma("unroll") for (int n = 0; n < 2; ++n) _Pragma("unroll") for (int k = 0; k < 2; ++k) \
        acc[ai][bj][m][n] = __builtin_amdgcn_mfma_f32_16x16x32_bf16(Bt[n][k], At[m][k], acc[ai][bj][m][n], 0, 0, 0); __builtin_amdgcn_s_setprio(0); } while (0)
#define PG8_WAIT_V(n) asm volatile("s_waitcnt vmcnt(" #n ")" ::: "memory")
#define PG8_WAIT_L(n) asm volatile("s_waitcnt lgkmcnt(" #n ")" ::: "memory")
#define PG8_BAR __builtin_amdgcn_s_barrier()
#define PG8_SCHED __builtin_amdgcn_sched_barrier(0)
    Unit cur, nxt; int ui = 0;
    if (!S.next(0, cur)) return;
    f32x4 acc[2][2][4][2];
#pragma unroll
    for (int a = 0; a < 2; ++a)
#pragma unroll
        for (int b = 0; b < 2; ++b)
#pragma unroll
            for (int m = 0; m < 4; ++m)
#pragma unroll
                for (int n = 0; n < 2; ++n) acc[a][b][m][n] = (f32x4){0.f, 0.f, 0.f, 0.f};
    bf16x8 At[4][2], B0[2][2], B1[2][2];
    const char* cA = (const char*)g.A + (size_t)cur.pm * tstep; const char* cB = (const char*)g.Bt + (size_t)cur.pn * tstep;
    S.a_ready(cur);
    if constexpr (SP2) {
        PG8_STAGE(PG8_SB(0, 0), cB, voffB); PG8_STAGE(PG8_SB(0, 1), cB + hstep, voffB); PG8_STAGE(PG8_SA(0, 0), cA, voffA); PG8_STAGE(PG8_SA(0, 1), cA + hstep, voffA);
        if (wr == 1) PG8_BAR;
        PG8_WAIT_V(2); PG8_BAR;
        PG8_STAGE(PG8_SB(1, 0), cB + kstep, voffB); PG8_STAGE(PG8_SA(1, 0), cA + kstep, voffA); PG8_STAGE(PG8_SB(1, 1), cB + hstep + kstep, voffB);
        PG8_WAIT_V(6); PG8_BAR;
    } else {
        PG8_STAGE(PG8_SB(0, 0), cB, voffB); PG8_STAGE(PG8_SA(0, 0), cA, voffA); PG8_STAGE(PG8_SB(0, 1), cB + hstep, voffB); PG8_STAGE(PG8_SA(0, 1), cA + hstep, voffA);
        if (wr == 1) PG8_BAR;
        PG8_WAIT_V(4); PG8_BAR;
        PG8_STAGE(PG8_SB(1, 0), cB + kstep, voffB); PG8_STAGE(PG8_SA(1, 0), cA + kstep, voffA); PG8_STAGE(PG8_SB(1, 1), cB + hstep + kstep, voffB);
        PG8_WAIT_V(6); PG8_BAR;
    }
    for (;;) {
        const bool has_next = S.next(ui + 1, nxt);
        const char* nA = has_next ? (const char*)g.A + (size_t)nxt.pm * tstep : cA; const char* nB = has_next ? (const char*)g.Bt + (size_t)nxt.pn * tstep : cB;
        for (int t = 0; t < nt; t += 2) {
            const bool last = (t == nt - 2);
            const char* a1 = cA + (size_t)(t + 1) * kstep;
            const char* a2 = last ? nA : cA + (size_t)(t + 2) * kstep; const char* b2 = last ? nB : cB + (size_t)(t + 2) * kstep;
            const char* a3 = a2 + kstep; const char* b3 = b2 + kstep;
            if (last && has_next) S.a_ready(nxt);
            if constexpr (SP2) {
            PG8_LDB(B0, 0, 0); PG8_LDB(B1, 0, 1); PG8_SCHED; PG8_LDA(At, 0, 0); PG8_STAGE(PG8_SA(1, 1), a1 + hstep, voffA);
            PG8_WAIT_V(8); PG8_WAIT_L(0); PG8_BAR; PG8_MMA(0, 0, At, B0); PG8_MMA(0, 1, At, B1); PG8_BAR; PG8_SCHED;
            PG8_LDA(At, 0, 1); PG8_STAGE(PG8_SB(0, 0), b2, voffB); PG8_STAGE(PG8_SB(0, 1), b2 + hstep, voffB); PG8_STAGE(PG8_SA(0, 0), a2, voffA);
            PG8_WAIT_V(8); PG8_WAIT_L(0); PG8_BAR; PG8_MMA(1, 0, At, B0); PG8_MMA(1, 1, At, B1); PG8_BAR; PG8_SCHED;
            PG8_LDB(B0, 1, 0); PG8_LDB(B1, 1, 1); PG8_SCHED; PG8_LDA(At, 1, 0); PG8_STAGE(PG8_SA(0, 1), a2 + hstep, voffA);
            PG8_WAIT_V(8); PG8_WAIT_L(0); PG8_BAR; PG8_MMA(0, 0, At, B0); PG8_MMA(0, 1, At, B1); PG8_BAR; PG8_SCHED;
            PG8_LDA(At, 1, 1); PG8_STAGE(PG8_SB(1, 0), b3, voffB); PG8_STAGE(PG8_SB(1, 1), b3 + hstep, voffB); PG8_STAGE(PG8_SA(1, 0), a3, voffA);
            PG8_WAIT_V(8); PG8_WAIT_L(0); PG8_BAR; PG8_MMA(1, 0, At, B0); PG8_MMA(1, 1, At, B1); PG8_BAR; PG8_SCHED;
            } else {
            PG8_LDB(B0, 0, 0); PG8_SCHED; PG8_LDA(At, 0, 0); PG8_STAGE(PG8_SA(1, 1), a1 + hstep, voffA);
            PG8_WAIT_L(8); PG8_BAR; PG8_WAIT_L(0); PG8_MMA(0, 0, At, B0); PG8_BAR; PG8_SCHED;
            PG8_LDB(B1, 0, 1); PG8_STAGE(PG8_SB(0, 0), b2, voffB);
            PG8_BAR; PG8_WAIT_L(0); PG8_MMA(0, 1, At, B1); PG8_BAR;
            PG8_LDA(At, 0, 1); PG8_STAGE(PG8_SA(0, 0), a2, voffA);
            PG8_BAR; PG8_WAIT_L(0); PG8_MMA(1, 0, At, B0); PG8_BAR; PG8_SCHED;
            PG8_STAGE(PG8_SB(0, 1), b2 + hstep, voffB);
            PG8_WAIT_V(6); PG8_BAR; PG8_MMA(1, 1, At, B1); PG8_BAR;
            PG8_LDB(B0, 1, 0); PG8_SCHED; PG8_LDA(At, 1, 0); PG8_STAGE(PG8_SA(0, 1), a2 + hstep, voffA);
            PG8_WAIT_L(8); PG8_BAR; PG8_WAIT_L(0); PG8_MMA(0, 0, At, B0); PG8_BAR; PG8_SCHED;
            PG8_LDB(B1, 1, 1); PG8_STAGE(PG8_SB(1, 0), b3, voffB);
            PG8_BAR; PG8_WAIT_L(0); PG8_MMA(0, 1, At, B1); PG8_BAR;
            PG8_LDA(At, 1, 1); PG8_STAGE(PG8_SA(1, 0), a3, voffA);
            PG8_BAR; PG8_WAIT_L(0); PG8_MMA(1, 0, At, B0); PG8_BAR; PG8_SCHED;
            PG8_STAGE(PG8_SB(1, 1), b3 + hstep, voffB);
            PG8_WAIT_V(6); PG8_BAR; PG8_MMA(1, 1, At, B1); PG8_BAR;
            }
        }
        if constexpr (ALIGN_EPI) { if (wr == 0) PG8_BAR; }
        if constexpr (!Epi::AFTER_DRAIN) { E(acc, cur, wr, wc, fr, fq); S.done(cur); }
        if (!has_next) break;
        if (!E.chain(cur)) {
#pragma unroll
        for (int a = 0; a < 2; ++a)
#pragma unroll
            for (int b = 0; b < 2; ++b)
#pragma unroll
                for (int m = 0; m < 4; ++m)
#pragma unroll
                    for (int n = 0; n < 2; ++n) acc[a][b][m][n] = (f32x4){0.f, 0.f, 0.f, 0.f};
        }
        cur = nxt; cA = nA; cB = nB; ++ui;
        if constexpr (ALIGN_EPI) { if (wr == 1) PG8_BAR; }
    }
    PG8_WAIT_V(0);
    if constexpr (!ALIGN_EPI) { if (wr == 0) PG8_BAR; }
    PG8_BAR;
    if constexpr (Epi::AFTER_DRAIN) { E.fused(acc, cur, wr, wc, fr, fq, lds, wid, lane); S.done(cur); }
#undef PG8_SA
#undef PG8_SB
#undef PG8_STAGE
#undef PG8_LDA
#undef PG8_LDB
#undef PG8_MMA
#undef PG8_WAIT_V
#undef PG8_WAIT_L
#undef PG8_BAR
#undef PG8_SCHED
}
}

constexpr int NB = 16, SEQ = 2048, DM = 1024, CTXL = 256, LALL = SEQ + CTXL;
constexpr int ML = NB * SEQ, MC = NB * CTXL, MALL = ML + MC;
constexpr int NIN = 8192, NHEAD = 8;
constexpr float NORM_EPS = 1e-6f;
constexpr float LAM_INIT = 0.2f;

#define LAS __attribute__((address_space(3)))
typedef pg8::bf16_t bf16_t;
typedef pg8::bf16x8 bf16x8;
typedef pg8::f32x4 f32x4;
typedef pg8::u32x4 u32x4;
typedef float f32x16 __attribute__((ext_vector_type(16)));
typedef float f32x2 __attribute__((ext_vector_type(2)));
typedef unsigned u32x2 __attribute__((ext_vector_type(2)));
typedef short s16x4 __attribute__((ext_vector_type(4)));
typedef __bf16 bf16x2_t __attribute__((ext_vector_type(2)));

constexpr size_t MiB = 1u << 20;
constexpr size_t WS_MODF = 0;
constexpr size_t WS_ROPE = 256 * 1024;
constexpr size_t WS_BAR = 1 * MiB, WS_BAR_BYTES = 16384;
constexpr int LDS_BARW = 131072 + 64;
constexpr size_t WS_WIN = 2 * MiB;
constexpr size_t WS_WA = 18 * MiB, WS_WL = 20 * MiB, WS_WO = 22 * MiB;
constexpr size_t WS_XN = 24 * MiB;
constexpr size_t WS_Q = 96 * MiB;
constexpr size_t WS_GR = 160 * MiB;
constexpr size_t WS_GA = 224 * MiB;
constexpr size_t WS_KA = 288 * MiB;
constexpr size_t WS_VA = 360 * MiB;
constexpr size_t WS_T = 288 * MiB;
constexpr size_t WS_XR = 432 * MiB;
constexpr size_t WS_PART = 504 * MiB;
constexpr size_t WS_END = 506 * MiB;

constexpr int LDS_BYTES = 147456;

__device__ __forceinline__ unsigned pk_bf16(float lo, float hi) { f32x2 v = {lo, hi}; bf16x2_t b = __builtin_convertvector(v, bf16x2_t); return __builtin_bit_cast(unsigned, b); }
__device__ __forceinline__ float bf_lo(unsigned u) { return __uint_as_float(u << 16); }
__device__ __forceinline__ float bf_hi(unsigned u) { return __uint_as_float(u & 0xffff0000u); }
__device__ __forceinline__ float sigmoidf_(float v) { return __builtin_amdgcn_rcpf(1.0f + __builtin_amdgcn_exp2f(-1.4426950408889634f * v)); }
__device__ __forceinline__ float siluf_(float v) { return v * sigmoidf_(v); }
#define LDS_BARRIER() do { asm volatile("s_waitcnt lgkmcnt(0)" ::: "memory"); __builtin_amdgcn_s_barrier(); asm volatile("" ::: "memory"); } while (0)

struct InProjOrder {
    pg8::StaticOrder S; int G, c;
    __device__ void init(int G_, int c_) { S.init(ML, NIN, G_, c_); G = G_; c = c_; }
    __device__ bool next(int i, pg8::Unit& u) const {
        const long L = (long)i * G + c;
        if (L < 4096) return S.next(i, u);
        const int j = (int)(L - 4096); if (j >= 192) return false;
        u.pm = 128 + (j & 15); const int q = j >> 4; u.pn = q < 8 ? 4 + q : 8 + q;
        return true;
    }
    __device__ __forceinline__ void a_ready(const pg8::Unit&) const {}
    __device__ __forceinline__ void done(const pg8::Unit&) const {}
};

struct EpiInProj {
    static constexpr bool PERM = true, AFTER_DRAIN = false;
    __device__ __forceinline__ bool chain(const pg8::Unit&) const { return false; }
    bf16_t *Q, *KA, *VA, *GA, *XR, *GR, *GM; const f32x2* rope;
    __device__ __forceinline__ void operator()(const f32x4 (&acc)[2][2][4][2], const pg8::Unit& u, int wr, int wc, int fr, int fq) const {
        const int pn = u.pn, pm = u.pm;
        const bool lat = pm < 128;
        const int b = lat ? (pm >> 3) : (pm - 128);
        const int tb = lat ? ((pm & 7) << 8) : 0;
        const int seg = pn >> 2;
        bf16_t* base; int pitch = 1024; size_t row0; int col0 = (pn & 3) * 256; int mode = 0;
        const size_t rowL = (size_t)b * SEQ + tb, rowA = (size_t)b * LALL + (lat ? CTXL : 0) + tb;
        float qs = 1.0f;
        if (seg == 0) { base = Q; row0 = rowL; mode = 1; qs = 0.125f * 1.4426950408889634f; }
        else if (seg == 1) { base = KA; row0 = rowA; mode = lat ? 1 : 0; }
        else if (seg == 2) { base = VA; row0 = rowA; }
        else if (seg == 3) { base = GA; row0 = rowL; mode = 2; }
        else if (seg == 4) { base = XR; row0 = rowA; }
        else if (seg == 5) { base = GR; row0 = rowL; mode = 2; }
        else { base = GM; pitch = 2048; row0 = rowL; col0 = (pn - 24) * 256; mode = 3; }
        const int lcol = wc * 32 + 8 * fq;
        const float sgn = (fq & 2) ? 1.0f : -1.0f;
#pragma unroll
        for (int ai = 0; ai < 2; ++ai)
#pragma unroll
            for (int m = 0; m < 4; ++m) {
                const int rloc = ai * 128 + wr * 64 + m * 16 + fr;
                bf16_t* rowp = base + (row0 + rloc) * (size_t)pitch + col0 + lcol;
                const int pos = (wc & 1) ? (m * 16 + fr) : ((tb >> 6) + 2 * ai + wr);
                const f32x4* rp = (const f32x4*)(rope + pos * 16 + 8 * (fq & 1));
#pragma unroll
                for (int bj = 0; bj < 2; ++bj) {
                    f32x4 v[2] = {acc[ai][bj][m][0], acc[ai][bj][m][1]};
                    if (mode == 1) {
#pragma unroll
                        for (int n = 0; n < 2; ++n) {
                            f32x4 p;
#pragma unroll
                            for (int i = 0; i < 4; ++i) p[i] = __shfl_xor(v[n][i], 32);
                            const f32x4 c0 = rp[2 * n], c1 = rp[2 * n + 1];
                            v[n][0] = (v[n][0] * c0[0] + sgn * p[0] * c0[1]) * qs;
                            v[n][1] = (v[n][1] * c0[2] + sgn * p[1] * c0[3]) * qs;
                            v[n][2] = (v[n][2] * c1[0] + sgn * p[2] * c1[1]) * qs;
                            v[n][3] = (v[n][3] * c1[2] + sgn * p[3] * c1[3]) * qs;
                            asm volatile("" ::: "memory");
                        }
                    } else if (mode == 2) {
#pragma unroll
                        for (int n = 0; n < 2; ++n)
#pragma unroll
                            for (int i = 0; i < 4; ++i) v[n][i] = siluf_(v[n][i]);
                    } else if (mode == 3) {
#pragma unroll
                        for (int n = 0; n < 2; ++n)
#pragma unroll
                            for (int i = 0; i < 4; ++i) v[n][i] = sigmoidf_(v[n][i]);
                    }
                    u32x4 w; w.x = pk_bf16(v[0][0], v[0][1]); w.y = pk_bf16(v[0][2], v[0][3]); w.z = pk_bf16(v[1][0], v[1][1]); w.w = pk_bf16(v[1][2], v[1][3]);
                    *(u32x4*)(rowp + bj * 128) = w;
                }
                asm volatile("" ::: "memory");
            }
    }
};

struct PairOrder {
    pg8::StaticOrder S;
    __device__ void init(int G_, int c_) { S.init(ML, 1024, G_, c_); }
    __device__ bool next(int i, pg8::Unit& u) const { if (!S.next(i >> 1, u)) return false; if (i & 1) { u.pm += 128; u.pn += 4; } return true; }
    __device__ __forceinline__ void a_ready(const pg8::Unit&) const {}
    __device__ __forceinline__ void done(const pg8::Unit&) const {}
};
struct EpiMerge {
    static constexpr bool PERM = true, AFTER_DRAIN = false;
    const bf16_t* GM; bf16_t* MB;
    __device__ __forceinline__ bool chain(const pg8::Unit& u) const { return u.pm < 128; }
    __device__ __forceinline__ void operator()(f32x4 (&acc)[2][2][4][2], const pg8::Unit& u, int wr, int wc, int fr, int fq) const {
        const bool first = u.pm < 128;
        const int pm = first ? u.pm : u.pm - 128, pn = first ? u.pn : u.pn - 4;
#pragma unroll
        for (int ai = 0; ai < 2; ++ai)
#pragma unroll
            for (int m = 0; m < 4; ++m) {
                const size_t row = (size_t)pm * 256 + ai * 128 + wr * 64 + m * 16 + fr;
#pragma unroll
                for (int bj = 0; bj < 2; ++bj) {
                    const int col = pn * 256 + bj * 128 + wc * 32 + 8 * fq;
                    const u32x4 gl = *(const u32x4*)(GM + row * 2048 + 1024 + col);
                    float ml[8] = {bf_lo(gl.x), bf_hi(gl.x), bf_lo(gl.y), bf_hi(gl.y), bf_lo(gl.z), bf_hi(gl.z), bf_lo(gl.w), bf_hi(gl.w)};
                    if (first) {
                        const u32x4 ga = *(const u32x4*)(GM + row * 2048 + col);
                        const float ma[8] = {bf_lo(ga.x), bf_hi(ga.x), bf_lo(ga.y), bf_hi(ga.y), bf_lo(ga.z), bf_hi(ga.z), bf_lo(ga.w), bf_hi(ga.w)};
#pragma unroll
                        for (int i = 0; i < 4; ++i) { acc[ai][bj][m][0][i] *= ma[i] * __builtin_amdgcn_rcpf(fmaxf(ml[i], 1e-30f)); acc[ai][bj][m][1][i] *= ma[4 + i] * __builtin_amdgcn_rcpf(fmaxf(ml[4 + i], 1e-30f)); }
                    } else {
                        const f32x4 a0 = acc[ai][bj][m][0], a1 = acc[ai][bj][m][1];
                        u32x4 w; w.x = pk_bf16(a0[0] * ml[0], a0[1] * ml[1]); w.y = pk_bf16(a0[2] * ml[2], a0[3] * ml[3]); w.z = pk_bf16(a1[0] * ml[4], a1[1] * ml[5]); w.w = pk_bf16(a1[2] * ml[6], a1[3] * ml[7]);
                        *(u32x4*)(MB + row * 1024 + col) = w;
                    }
                }
                asm volatile("" ::: "memory");
            }
    }
};
struct EpiOut {
    static constexpr bool PERM = true, AFTER_DRAIN = false;
    __device__ __forceinline__ bool chain(const pg8::Unit&) const { return false; }
    bf16_t* Y; float* PART;
    __device__ __forceinline__ void operator()(const f32x4 (&acc)[2][2][4][2], const pg8::Unit& u, int wr, int wc, int fr, int fq) const {
#pragma unroll
        for (int ai = 0; ai < 2; ++ai)
#pragma unroll
            for (int m = 0; m < 4; ++m) {
                const size_t row = (size_t)u.pm * 256 + ai * 128 + wr * 64 + m * 16 + fr;
                float ss = 0.f;
#pragma unroll
                for (int bj = 0; bj < 2; ++bj) {
                    const int col = u.pn * 256 + bj * 128 + wc * 32 + 8 * fq;
                    const f32x4 a0 = acc[ai][bj][m][0], a1 = acc[ai][bj][m][1];
                    u32x4 w; w.x = pk_bf16(a0[0], a0[1]); w.y = pk_bf16(a0[2], a0[3]); w.z = pk_bf16(a1[0], a1[1]); w.w = pk_bf16(a1[2], a1[3]);
                    *(u32x4*)(Y + row * 1024 + col) = w;
                    ss += (a0[0] * a0[0] + a0[1] * a0[1]) + (a0[2] * a0[2] + a0[3] * a0[3]) + (a1[0] * a1[0] + a1[1] * a1[1]) + (a1[2] * a1[2] + a1[3] * a1[3]);
                }
                ss += __shfl_xor(ss, 16); ss += __shfl_xor(ss, 32);
                if (fq == 0) PART[row * 16 + u.pn * 4 + wc] = ss;
            }
    }
};

struct Params {
    const float *x, *c, *ctx, *c_ctx, *w_mod, *b_mod, *g_pre, *g_post, *w_in, *lq1, *lk1, *lq2, *lk2, *g_subln, *w_attn_out, *conv_w, *conv_b,
                *w_rg_a, *b_rg_a, *w_rg_x, *b_rg_x, *lru_lambda, *w_lru_out, *w_out;
    float* out; unsigned char* ws;
};

typedef const __attribute__((address_space(4))) Params* KP;

__device__ __forceinline__ float wave_sum(float v) {
#pragma unroll
    for (int o = 1; o < 64; o <<= 1) v += __shfl_xor(v, o);
    return v;
}

__device__ __forceinline__ void transpose_item(const float* W, int K, int N, bf16_t* WT, LAS float* scr, int item, int lane) {
    const int nblk = N / 32, kb = item / nblk, nb = item % nblk, k0 = 64 * kb, n0 = 32 * nb;
#pragma unroll 8
    for (int i = 0; i < 32; ++i) { const int kk = 2 * i + (lane >> 5); scr[kk * 33 + (lane & 31)] = W[(size_t)(k0 + kk) * N + n0 + (lane & 31)]; }
    asm volatile("s_waitcnt lgkmcnt(0)" ::: "memory");
    const int c = lane & 7;
#pragma unroll
    for (int j = 0; j < 4; ++j) { const int n = (lane >> 3) + 8 * j; const LAS float* s = scr + (8 * c) * 33 + n;
        u32x4 o; o.x = pk_bf16(s[0 * 33], s[1 * 33]); o.y = pk_bf16(s[2 * 33], s[3 * 33]); o.z = pk_bf16(s[4 * 33], s[5 * 33]); o.w = pk_bf16(s[6 * 33], s[7 * 33]);
        *(u32x4*)(WT + (size_t)(n0 + n) * K + k0 + 8 * c) = o; }
    asm volatile("s_waitcnt lgkmcnt(0)" ::: "memory");
}

__device__ __forceinline__ void phase0a(KP P, unsigned char* lds, int tid, int wid, int lane) {
    unsigned char* ws = P->ws;
    const int G = gridDim.x, bx = blockIdx.x;
    for (int item = bx; item < 48; item += G) {
        float* s = (float*)lds;
        float* red = (float*)(lds + 17 * 1024 * 4);
        for (int idx = tid; idx < 17 * 1024; idx += 512) { const int bb = idx >> 10, k = idx & 1023; const float v = bb < 16 ? P->c[bb * 1024 + k] : P->c_ctx[k]; s[idx] = siluf_(v); }
        __syncthreads();
        const int n = item * 64 + lane, k0 = wid * 128;
        float acc[17];
#pragma unroll
        for (int bb = 0; bb < 17; ++bb) acc[bb] = 0.f;
#pragma unroll 4
        for (int k = k0; k < k0 + 128; ++k) {
            const float w = P->w_mod[(size_t)k * 3072 + n];
#pragma unroll
            for (int bb = 0; bb < 17; ++bb) acc[bb] += s[bb * 1024 + k] * w;
        }
#pragma unroll
        for (int bb = 0; bb < 17; ++bb) red[(wid * 17 + bb) * 64 + lane] = acc[bb];
        __syncthreads();
        float* MODF = (float*)(ws + WS_MODF);
        for (int idx = tid; idx < 17 * 64; idx += 512) {
            const int bb = idx >> 6, l = idx & 63; float sum = 0.f;
#pragma unroll
            for (int w = 0; w < 8; ++w) sum += red[(w * 17 + bb) * 64 + l];
            MODF[bb * 3072 + item * 64 + l] = sum + P->b_mod[item * 64 + l];
        }
        __syncthreads();
    }
    if (bx == (48 % G)) {
        f32x2* rope = (f32x2*)(ws + WS_ROPE);
        for (int idx = tid; idx < 1024; idx += 512) {
            const int pos = idx >> 4, f = idx & 15;
            const float inv = powf(10000.0f, -(float)(2 * f) / 32.0f);
            const float ang = (float)pos * inv;
            rope[idx] = (f32x2){cosf(ang), sinf(ang)};
        }
    }
    LAS float* scr = (LAS float*)((LAS unsigned char*)lds + wid * 16384);
    const int gw = bx * 8 + wid, NGW = G * 8;
    constexpr int I_IN = 16 * 256, I_SQ = 16 * 32;
    for (int it = gw; it < I_IN + 3 * I_SQ; it += NGW) {
        int r = it;
        if (r < I_IN) { transpose_item(P->w_in, 1024, NIN, (bf16_t*)(ws + WS_WIN), scr, r, lane); continue; } r -= I_IN;
        if (r < I_SQ) { transpose_item(P->w_attn_out, 1024, 1024, (bf16_t*)(ws + WS_WA), scr, r, lane); continue; } r -= I_SQ;
        if (r < I_SQ) { transpose_item(P->w_lru_out, 1024, 1024, (bf16_t*)(ws + WS_WL), scr, r, lane); continue; } r -= I_SQ;
        transpose_item(P->w_out, 1024, 1024, (bf16_t*)(ws + WS_WO), scr, r, lane);
    }
}

__device__ __forceinline__ void phase0b(KP P, int wid, int lane) {
    const float* MODF = (const float*)(P->ws + WS_MODF);
    bf16_t* XN = (bf16_t*)(P->ws + WS_XN);
    const int gw = blockIdx.x * 8 + wid, NGW = gridDim.x * 8;
    const int per = (MALL + NGW - 1) / NGW;
    int r0 = gw * per, r1 = r0 + per; if (r1 > MALL) r1 = MALL;
    f32x4 g[4], sc[4], sh[4];
#pragma unroll
    for (int j = 0; j < 4; ++j) g[j] = *(const f32x4*)(P->g_pre + 4 * lane + 256 * j);
    int cur = -1;
    for (int row = r0; row < r1; ++row) {
        const int bb = row < ML ? (row >> 11) : 16;
        if (bb != cur) {
            cur = bb;
#pragma unroll
            for (int j = 0; j < 4; ++j) { sh[j] = *(const f32x4*)(MODF + bb * 3072 + 4 * lane + 256 * j); sc[j] = *(const f32x4*)(MODF + bb * 3072 + 1024 + 4 * lane + 256 * j);
                sc[j] = (sc[j] + 1.0f) * g[j]; }
        }
        const float* xr = row < ML ? P->x + (size_t)row * 1024 : P->ctx + (size_t)(row - ML) * 1024;
        f32x4 v[4]; float s = 0.f;
#pragma unroll
        for (int j = 0; j < 4; ++j) { v[j] = *(const f32x4*)(xr + 4 * lane + 256 * j); s += (v[j][0] * v[j][0] + v[j][1] * v[j][1]) + (v[j][2] * v[j][2] + v[j][3] * v[j][3]); }
        const float rstd = rsqrtf(wave_sum(s) * (1.0f / 1024.0f) + NORM_EPS);
#pragma unroll
        for (int j = 0; j < 4; ++j) {
            const f32x4 o = v[j] * rstd * sc[j] + sh[j];
            u32x2 w; w.x = pk_bf16(o[0], o[1]); w.y = pk_bf16(o[2], o[3]);
            *(u32x2*)(XN + (size_t)row * 1024 + 4 * lane + 256 * j) = w;
        }
    }
}

constexpr int LRU_DIRB = 59392;
constexpr int LRU_XCF = 0;
constexpr int LRU_XCB = 16384;
constexpr int LRU_SA = 16384 + 9216;
constexpr int LRU_SU = LRU_SA + 4 * 1040 * 4;
constexpr int LRU_CARRY = LRU_SU + 4 * 1040 * 4;
constexpr int LRU_CW = 2 * LRU_DIRB;
static_assert(LRU_CARRY + 256 <= LRU_DIRB && LRU_CW + 5 * 64 * 4 <= 131072, "lru lds");

__device__ __forceinline__ void lru_unit(KP P, unsigned char* lds_g, bf16_t* ZLOUT, int b, int nb, int tid, int wid, int lane) {
    unsigned char* ws = P->ws;
    LAS unsigned char* lds = (LAS unsigned char*)lds_g;
    const bf16_t* XR = (const bf16_t*)(ws + WS_XR) + (size_t)b * LALL * 1024 + nb * 64;
    bf16_t* HF = (bf16_t*)(ws + WS_XN) + (size_t)b * SEQ * 1024 + nb * 64;
    const bf16_t* GRZ = (const bf16_t*)(ws + WS_GR) + (size_t)b * SEQ * 1024 + nb * 64;
    bf16_t* ZL = ZLOUT + (size_t)b * SEQ * 1024 + nb * 64;
    const int tok = tid >> 3, cc = tid & 7;
    const unsigned aoff = tok * 1024 + cc * 8;
    if (tid < 320) { const int j = tid >> 6, ch = tid & 63; ((LAS float*)(lds + LRU_CW))[tid] = j < 4 ? P->conv_w[j * 1024 + nb * 64 + ch] : P->conv_b[nb * 64 + ch]; }
    const LAS float* cwl = (const LAS float*)(lds + LRU_CW) + cc * 8;
    const int wdir = wid >> 2, w4 = wid & 3;
    LAS unsigned char* ldsd = lds + wdir * LRU_DIRB;
    const int tt = w4 & 1, nh = w4 >> 1, hh = lane >> 5, jch = nh * 32 + (lane & 31), chB = nb * 64 + jch;
    const int sc_c = 16 * w4 + (lane & 15), sc_seg = lane >> 4;
    bf16x8 wA[4], wX[4];
    {
        const float* wa = P->w_rg_a + (size_t)(wdir * 16 + nb) * 4096 + jch;
        const float* wx = P->w_rg_x + (size_t)(wdir * 16 + nb) * 4096 + jch;
#pragma unroll
        for (int ks = 0; ks < 4; ++ks) {
            unsigned ua[4], ux[4];
#pragma unroll
            for (int j2 = 0; j2 < 4; ++j2) {
                const int i0 = 16 * ks + 8 * hh + 2 * j2;
                ua[j2] = pk_bf16(wa[i0 * 64], wa[(i0 + 1) * 64]);
                ux[j2] = pk_bf16(wx[i0 * 64], wx[(i0 + 1) * 64]);
            }
            wA[ks] = __builtin_bit_cast(bf16x8, (u32x4){ua[0], ua[1], ua[2], ua[3]});
            wX[ks] = __builtin_bit_cast(bf16x8, (u32x4){ux[0], ux[1], ux[2], ux[3]});
        }
    }
    const float ba2 = -1.4426950408889634f * P->b_rg_a[wdir * 1024 + chB], bx2 = -1.4426950408889634f * P->b_rg_x[wdir * 1024 + chB];
    const float sp8 = -8.0f * 1.4426950408889634f * log1pf(__expf(-P->lru_lambda[wdir * 1024 + chB]));
    if (tid < 64) { ((LAS float*)(lds + LRU_CARRY))[tid] = 0.f; ((LAS float*)(lds + LRU_DIRB + LRU_CARRY))[tid] = 0.f; }
    u32x4 xr[2][4];
#define LRU_LOAD_XR(IT) do { const int cf_ = (IT), cb_ = (IT) < 4 ? 3 - (IT) : 39 - (IT); \
        _Pragma("unroll") for (int d = 0; d < 2; ++d) { const int ci = d ? cb_ : cf_, lo = ci < 4 ? 0 : CTXL, hi = ci < 4 ? CTXL : LALL; \
            _Pragma("unroll") for (int j = 0; j < 4; ++j) { const int pp = ci * 64 + tok - 1 + j; xr[d][j] = (u32x4){0u, 0u, 0u, 0u}; \
                if (pp >= lo && pp < hi) xr[d][j] = *(const u32x4*)(XR + (ptrdiff_t)(ci * 64 - 1 + j) * 1024 + aoff); } } } while (0)
    LRU_LOAD_XR(0);
    __syncthreads();
#pragma unroll 1
    for (int it = 0; it < 36; ++it) {
        const int cf = it, cb = it < 4 ? 3 - it : 39 - it;
        {
            float xc[2][8];
            { const f32x4 c0 = *(const LAS f32x4*)(cwl + 256), c1 = *(const LAS f32x4*)(cwl + 260);
#pragma unroll
              for (int d = 0; d < 2; ++d) { xc[d][0] = c0[0]; xc[d][1] = c0[1]; xc[d][2] = c0[2]; xc[d][3] = c0[3]; xc[d][4] = c1[0]; xc[d][5] = c1[1]; xc[d][6] = c1[2]; xc[d][7] = c1[3]; } }
#pragma unroll
            for (int j = 0; j < 4; ++j) {
                const f32x4 w0 = *(const LAS f32x4*)(cwl + j * 64), w1 = *(const LAS f32x4*)(cwl + j * 64 + 4);
#pragma unroll
                for (int d = 0; d < 2; ++d) {
                    const u32x4 v = xr[d][j];
                    xc[d][0] += w0[0] * bf_lo(v.x); xc[d][1] += w0[1] * bf_hi(v.x); xc[d][2] += w0[2] * bf_lo(v.y); xc[d][3] += w0[3] * bf_hi(v.y);
                    xc[d][4] += w1[0] * bf_lo(v.z); xc[d][5] += w1[1] * bf_hi(v.z); xc[d][6] += w1[2] * bf_lo(v.w); xc[d][7] += w1[3] * bf_hi(v.w);
                }
            }
#pragma unroll
            for (int d = 0; d < 2; ++d) {
                LAS float* XCF = (LAS float*)(lds + d * LRU_DIRB + LRU_XCF);
                LAS unsigned char* XCB = lds + d * LRU_DIRB + LRU_XCB;
                *(LAS f32x4*)(XCF + tok * 64 + cc * 8) = (f32x4){xc[d][0], xc[d][1], xc[d][2], xc[d][3]};
                *(LAS f32x4*)(XCF + tok * 64 + cc * 8 + 4) = (f32x4){xc[d][4], xc[d][5], xc[d][6], xc[d][7]};
                u32x4 w; w.x = pk_bf16(xc[d][0], xc[d][1]); w.y = pk_bf16(xc[d][2], xc[d][3]); w.z = pk_bf16(xc[d][4], xc[d][5]); w.w = pk_bf16(xc[d][6], xc[d][7]);
                *(LAS u32x4*)(XCB + tok * 144 + cc * 16) = w;
            }
        }
        if (it + 1 < 36) LRU_LOAD_XR(it + 1);
        u32x4 stg[2], stf[2];
#pragma unroll
        for (int d = 0; d < 2; ++d) {
            const int ci = d ? cb : cf; const bool first = d ? (ci >= 20) : (ci <= 19);
            stg[d] = (u32x4){0u, 0u, 0u, 0u}; stf[d] = stg[d];
            if (ci >= 4 && !first) { const size_t off = (size_t)(ci * 64 - CTXL) * 1024 + aoff; stg[d] = *(const u32x4*)(GRZ + off); stf[d] = *(const u32x4*)(HF + off); }
        }
        LDS_BARRIER();
        {
            const LAS unsigned char* XCB = ldsd + LRU_XCB;
            f32x16 accA = {}, accX = {};
#pragma unroll
            for (int ks = 0; ks < 4; ++ks) {
                const bf16x8 af = *(const LAS bf16x8*)(XCB + (32 * tt + (lane & 31)) * 144 + (16 * ks + 8 * hh) * 2);
                accA = __builtin_amdgcn_mfma_f32_32x32x16_bf16(af, wA[ks], accA, 0, 0, 0);
                accX = __builtin_amdgcn_mfma_f32_32x32x16_bf16(af, wX[ks], accX, 0, 0, 0);
            }
            const int sbase = wdir == 0 ? (2 * tt * 1040 + 4 * hh * 64 + jch) : ((3 - 2 * tt) * 1040 + (15 - 4 * hh) * 64 + jch - 1744);
            const LAS float* xcf = (const LAS float*)(ldsd + LRU_XCF) + (32 * tt + 4 * hh) * 64 + jch;
            LAS float* SA = (LAS float*)(ldsd + LRU_SA) + sbase;
            LAS float* SU = (LAS float*)(ldsd + LRU_SU) + sbase;
            float av[16], uv[16];
#pragma unroll
            for (int r = 0; r < 16; ++r) {
                const float ra = __builtin_amdgcn_rcpf(1.0f + __builtin_amdgcn_exp2f(accA[r] * -1.4426950408889634f + ba2));
                const float ix = __builtin_amdgcn_rcpf(1.0f + __builtin_amdgcn_exp2f(accX[r] * -1.4426950408889634f + bx2));
                av[r] = __builtin_amdgcn_exp2f(sp8 * ra);
                uv[r] = __builtin_amdgcn_sqrtf(1.0f - av[r] * av[r]) * ix * xcf[(8 * (r >> 2) + (r & 3)) * 64];
            }
            if (wdir == 0) {
#pragma unroll
                for (int r = 0; r < 16; ++r) { const int cr = (r >> 3) * 1040 + (8 * ((r >> 2) & 1) + (r & 3)) * 64; SA[cr] = av[r]; SU[cr] = uv[r]; }
            } else {
#pragma unroll
                for (int r = 0; r < 16; ++r) { const int cr = (r >> 3) * 1040 + (8 * ((r >> 2) & 1) + (r & 3)) * 64; SA[1744 - cr] = av[r]; SU[1744 - cr] = uv[r]; }
            }
        }
        LDS_BARRIER();
        {
            LAS float* SA = (LAS float*)(ldsd + LRU_SA) + sc_seg * 1040 + sc_c;
            LAS float* SU = (LAS float*)(ldsd + LRU_SU) + sc_seg * 1040 + sc_c;
            LAS float* CARRY = (LAS float*)(ldsd + LRU_CARRY);
            float A = 1.f, U = 0.f;
#pragma unroll
            for (int s2 = 0; s2 < 16; ++s2) { const float a_ = SA[s2 * 64], u_ = SU[s2 * 64]; U = a_ * U + u_; A *= a_; }
#pragma unroll
            for (int d = 16; d < 64; d <<= 1) {
                const float Ap = __shfl_up(A, d), Up = __shfl_up(U, d);
                if (lane >= d) { U = A * Up + U; A = A * Ap; }
            }
            float Ae = __shfl_up(A, 16), Ue = __shfl_up(U, 16);
            if (sc_seg == 0) { Ae = 1.f; Ue = 0.f; }
            const float hc = CARRY[sc_c];
            float h = Ae * hc + Ue;
            if (sc_seg == 3) CARRY[sc_c] = A * hc + U;
#pragma unroll
            for (int s2 = 0; s2 < 16; ++s2) { h = SA[s2 * 64] * h + SU[s2 * 64]; SU[s2 * 64] = h; }
        }
        LDS_BARRIER();
#pragma unroll
        for (int d = 0; d < 2; ++d) {
            const int ci = d ? cb : cf;
            if (ci >= 4) {
                const int tau = d ? 63 - tok : tok;
                const LAS float* SU = (const LAS float*)(lds + d * LRU_DIRB + LRU_SU) + (tau >> 4) * 1040 + (tau & 15) * 64 + cc * 8;
                const f32x4 h0 = *(const LAS f32x4*)SU, h1 = *(const LAS f32x4*)(SU + 4);
                const size_t off = (size_t)(ci * 64 - CTXL) * 1024 + aoff;
                const bool first = d ? (ci >= 20) : (ci <= 19);
                if (first) {
                    u32x4 w; w.x = pk_bf16(h0[0], h0[1]); w.y = pk_bf16(h0[2], h0[3]); w.z = pk_bf16(h1[0], h1[1]); w.w = pk_bf16(h1[2], h1[3]);
                    *(u32x4*)(HF + off) = w;
                } else {
                    const u32x4 f = stf[d], g = stg[d];
                    u32x4 w;
                    w.x = pk_bf16((bf_lo(f.x) + h0[0]) * bf_lo(g.x), (bf_hi(f.x) + h0[1]) * bf_hi(g.x));
                    w.y = pk_bf16((bf_lo(f.y) + h0[2]) * bf_lo(g.y), (bf_hi(f.y) + h0[3]) * bf_hi(g.y));
                    w.z = pk_bf16((bf_lo(f.z) + h1[0]) * bf_lo(g.z), (bf_hi(f.z) + h1[1]) * bf_hi(g.z));
                    w.w = pk_bf16((bf_lo(f.w) + h1[2]) * bf_lo(g.w), (bf_hi(f.w) + h1[3]) * bf_hi(g.w));
                    *(u32x4*)(ZL + off) = w;
                }
            }
        }
    }
    __syncthreads();
}

constexpr int ATT_KSLOT = 8192, ATT_V0 = 3 * 8192, ATT_VBUF = 16384, ATT_STASH = ATT_V0 + 2 * ATT_VBUF;
__device__ __forceinline__ s16x4 vtr(const LAS unsigned char* p) { return __builtin_bit_cast(s16x4, __builtin_amdgcn_ds_read_tr16_b64_v4i16((LAS s16x4*)p)); }

__device__ __forceinline__ void attn_qk(const LAS unsigned char* lds, int kcur, const int (&kaddr)[4], const bf16x8 (&qf)[4], const f32x16& cinit, f32x16& p0, f32x16& p1) {
    p0 = cinit; p1 = cinit;
#pragma unroll
    for (int ks = 0; ks < 4; ++ks) {
        const bf16x8 k0 = *(const LAS bf16x8*)(lds + kcur + kaddr[ks]);
        const bf16x8 k1 = *(const LAS bf16x8*)(lds + kcur + kaddr[ks] + 4096);
        p0 = __builtin_amdgcn_mfma_f32_32x32x16_bf16(k0, qf[ks], p0, 0, 0, 0);
        p1 = __builtin_amdgcn_mfma_f32_32x32x16_bf16(k1, qf[ks], p1, 0, 0, 0);
    }
}
__device__ __forceinline__ void attn_tile(const LAS unsigned char* lds, int knext, int vcur, const int (&kaddr)[4], const int (&vaddr)[4], const bf16x8 (&qf)[4],
                                          f32x16& p0, f32x16& p1, f32x16& pn0, f32x16& pn1, f32x16 (&o)[4], float& m_ref, float& l, float& mx, f32x16& negm) {
    constexpr float THR = 8.0f;
    if (__builtin_amdgcn_ballot_w64(mx > m_ref + THR) != 0ull) {
        const float mf = fmaxf(mx, __shfl_xor(mx, 32));
        if (mf > m_ref + THR) {
            const float delta = mf - m_ref, alpha = __builtin_amdgcn_exp2f(-delta);
            l *= alpha;
#pragma unroll
            for (int d = 0; d < 4; ++d) o[d] = o[d] * alpha;
            p0 = p0 - delta; p1 = p1 - delta;
            m_ref = mf;
#pragma unroll
            for (int r = 0; r < 16; ++r) negm[r] = -mf;
        }
    }
    attn_qk(lds, knext, kaddr, qf, negm, pn0, pn1);
    unsigned pa[4][4];
    float ls = 0.f;
#pragma unroll
    for (int r = 0; r < 16; r += 2) {
        const float e0 = __builtin_amdgcn_exp2f(p0[r]), e1 = __builtin_amdgcn_exp2f(p0[r + 1]);
        const float f0 = __builtin_amdgcn_exp2f(p1[r]), f1 = __builtin_amdgcn_exp2f(p1[r + 1]);
        ls += (e0 + e1) + (f0 + f1);
        pa[r >> 3][(r & 7) >> 1] = pk_bf16(e0, e1);
        pa[2 + (r >> 3)][(r & 7) >> 1] = pk_bf16(f0, f1);
    }
    l += ls;
    {
        float mn = pn0[0];
#pragma unroll
        for (int r = 1; r < 16; ++r) mn = fmaxf(mn, pn0[r]);
#pragma unroll
        for (int r = 0; r < 16; ++r) mn = fmaxf(mn, pn1[r]);
        mx = mn + m_ref;
    }
    bf16x8 vf[2][4];
#define ATT_LDV(S, BUF) do { _Pragma("unroll") for (int dvt = 0; dvt < 4; ++dvt) { \
        const s16x4 lo = vtr(lds + vcur + vaddr[dvt] + (S) * 4096), hh2 = vtr(lds + vcur + vaddr[dvt] + (S) * 4096 + 2048); \
        vf[BUF][dvt] = (bf16x8){lo[0], lo[1], lo[2], lo[3], hh2[0], hh2[1], hh2[2], hh2[3]}; } } while (0)
    ATT_LDV(0, 0);
#pragma unroll
    for (int s = 0; s < 4; ++s) {
        if (s < 3) ATT_LDV(s + 1, (s + 1) & 1);
        const bf16x8 pb = __builtin_bit_cast(bf16x8, (u32x4){pa[s][0], pa[s][1], pa[s][2], pa[s][3]});
#pragma unroll
        for (int dvt = 0; dvt < 4; ++dvt) o[dvt] = __builtin_amdgcn_mfma_f32_32x32x16_bf16(vf[s & 1][dvt], pb, o[dvt], 0, 0, 0);
    }
#undef ATT_LDV
}

__device__ __forceinline__ void attn_unit(KP P, unsigned char* lds_g, bf16_t* ZOUT, int b, int h, int qb, float lam, int tid, int wid, int lane) {
    unsigned char* ws = P->ws;
    LAS unsigned char* lds = (LAS unsigned char*)lds_g;
    bf16_t* QZ = (bf16_t*)(ws + WS_Q);
    const bf16_t* KA = (const bf16_t*)(ws + WS_KA);
    const bf16_t* VA = (const bf16_t*)(ws + WS_VA);
    const bf16_t* GA = (const bf16_t*)(ws + WS_GA);
    const int q = lane & 31, hi = lane >> 5;
    const size_t qrow_u = ((size_t)b * SEQ + qb * 256 + wid * 32) * 1024 + h * 128;
    const unsigned qoff = q * 1024 + 8 * hi;
    constexpr float C2 = 0.125f * 1.4426950408889634f;
    constexpr float THR = 8.0f;
    unsigned koff; unsigned voff[2];
    { const int row = 8 * wid + (lane >> 3), pc = lane & 7; koff = row * 1024 + (pc ^ ((row >> 1) & 7)) * 8; }
#pragma unroll
    for (int i = 0; i < 2; ++i) { const int row = 4 * (2 * wid + i) + (lane >> 4), pc = lane & 15, c = (((pc >> 2) ^ (row & 3)) << 2) | (pc & 3); voff[i] = row * 1024 + c * 8; }
    const int kpiece = wid * 1024, vpiece = ATT_V0 + wid * 2048;
#define ATT_DMA(G, L) do { unsigned keep_; const void* g_ = (const void*)(G); const unsigned l_ = (unsigned)__builtin_amdgcn_readfirstlane((int)(unsigned)(uintptr_t)(L)); \
        asm volatile("s_mov_b32 %0, m0\n\ts_mov_b32 m0, %2\n\ts_nop 0\n\tglobal_load_lds_dwordx4 %1, off\n\ts_mov_b32 m0, %0" : "=&s"(keep_) : "v"(g_), "s"(l_) : "memory"); } while (0)
    int kaddr[4];
#pragma unroll
    for (int ks = 0; ks < 4; ++ks) kaddr[ks] = q * 128 + 16 * ((2 * ks + hi) ^ ((q >> 1) & 7));
    int vaddr[4];
    { const int g = lane >> 4, qq = (lane >> 2) & 3, pp = lane & 3, h2 = g >> 1;
#pragma unroll
      for (int dvt = 0; dvt < 4; ++dvt) vaddr[dvt] = ATT_V0 + (4 * h2 + qq) * 256 + ((dvt ^ qq) * 64) + (g & 1) * 32 + pp * 8; }

    LAS unsigned* o1s = (LAS unsigned*)(lds + ATT_STASH + wid * 8192) + lane;
    const bf16_t* Kb = KA + (size_t)b * LALL * 1024 + h * 128;
    const bf16_t* Vb = VA + (size_t)b * LALL * 1024 + h * 128;

#pragma unroll 1
    for (int pass = 0; pass < 2; ++pass) {
        bf16x8 qf[4];
#pragma unroll
        for (int ks = 0; ks < 4; ++ks) qf[ks] = *(const bf16x8*)(QZ + qrow_u + pass * 64 + 16 * ks + qoff);
        const bf16_t* Kp = Kb + pass * 64;
        f32x16 o[4];
#pragma unroll
        for (int d = 0; d < 4; ++d) o[d] = (f32x16){};
        float m_ref = -1e30f, l = 0.f;
        {
            ATT_DMA(Kp + koff, lds + kpiece); ATT_DMA(Kp + 65536 + koff, lds + ATT_KSLOT + kpiece);
            ATT_DMA(Vb + voff[0], lds + vpiece); ATT_DMA(Vb + voff[1], lds + vpiece + 1024);
            asm volatile("s_waitcnt vmcnt(0)" ::: "memory");
        }
        __syncthreads();
        asm volatile("" :: "v"(qf[0]), "v"(qf[1]), "v"(qf[2]), "v"(qf[3]));
        f32x16 pa0, pa1, pb0, pb1, negm = {};
        attn_qk(lds, 0, kaddr, qf, negm, pa0, pa1);
        float mxc = pa0[0];
#pragma unroll
        for (int r = 1; r < 16; ++r) mxc = fmaxf(mxc, pa0[r]);
#pragma unroll
        for (int r = 0; r < 16; ++r) mxc = fmaxf(mxc, pa1[r]);
        m_ref = fmaxf(mxc, __shfl_xor(mxc, 32));
        pa0 = pa0 - m_ref; pa1 = pa1 - m_ref;
#pragma unroll
        for (int r = 0; r < 16; ++r) negm[r] = -m_ref;
        int ks1 = ATT_KSLOT, ks2 = 2 * ATT_KSLOT;
#define ATT_STEP(T, PC0, PC1, PN0, PN1, VCUR, VNXT) do { \
            const size_t rk = (size_t)((T) + 2 < LALL / 64 ? (T) + 2 : LALL / 64 - 1) * 65536, rv = (size_t)((T) + 1 < LALL / 64 ? (T) + 1 : LALL / 64 - 1) * 65536; \
            ATT_DMA(Kp + rk + koff, lds + ks2 + kpiece); ATT_DMA(Vb + rv + voff[0], lds + (VNXT) + vpiece); ATT_DMA(Vb + rv + voff[1], lds + (VNXT) + vpiece + 1024); \
            attn_tile(lds, ks1, (VCUR), kaddr, vaddr, qf, PC0, PC1, PN0, PN1, o, m_ref, l, mxc, negm); \
            asm volatile("s_waitcnt vmcnt(0)" ::: "memory"); \
            { const int k3 = ks1 + ks2 == 3 * ATT_KSLOT ? 0 : (ks1 + ks2 == ATT_KSLOT ? 2 * ATT_KSLOT : ATT_KSLOT); ks1 = ks2; ks2 = k3; } \
            __syncthreads(); } while (0)
#pragma unroll 1
        for (int t = 0; t < LALL / 64; t += 2) {
            ATT_STEP(t, pa0, pa1, pb0, pb1, 0, ATT_VBUF);
            ATT_STEP(t + 1, pb0, pb1, pa0, pa1, ATT_VBUF, 0);
        }
#undef ATT_STEP
        const float lt = l + __shfl_xor(l, 32);
        const float inv = 1.0f / lt;
        if (pass == 0) {
#pragma unroll
            for (int d = 0; d < 4; ++d)
#pragma unroll
                for (int r = 0; r < 16; r += 2) o1s[(d * 8 + (r >> 1)) * 64] = pk_bf16(o[d][r] * inv, o[d][r + 1] * inv);
        } else {
            const float li = lam * inv;
            float ss = 0.f;
#pragma unroll
            for (int d = 0; d < 4; ++d) {
#pragma unroll
                for (int r = 0; r < 16; r += 2) {
                    const unsigned o1 = o1s[(d * 8 + (r >> 1)) * 64];
                    const float a0 = bf_lo(o1) - li * o[d][r], a1 = bf_hi(o1) - li * o[d][r + 1];
                    ss += a0 * a0 + a1 * a1;
                }
                asm volatile("" ::: "memory");
            }
            ss += __shfl_xor(ss, 32);
            const float rstd = rsqrtf(ss * (1.0f / 128.0f) + NORM_EPS) * (1.0f - LAM_INIT);
            const unsigned eoff = q * 1024 + 8 * hi;
#pragma unroll
            for (int d = 0; d < 4; ++d)
#pragma unroll
                for (int pr = 0; pr < 2; ++pr) {
                    float va[4], vb[4];
#pragma unroll
                    for (int i = 0; i < 4; i += 2) {
                        const unsigned oa = o1s[(d * 8 + 4 * pr + (i >> 1)) * 64], ob = o1s[(d * 8 + 4 * pr + 2 + (i >> 1)) * 64];
                        va[i] = bf_lo(oa) - li * o[d][8 * pr + i]; va[i + 1] = bf_hi(oa) - li * o[d][8 * pr + i + 1];
                        vb[i] = bf_lo(ob) - li * o[d][8 * pr + 4 + i]; vb[i + 1] = bf_hi(ob) - li * o[d][8 * pr + 4 + i + 1];
                    }
#pragma unroll
                    for (int i = 0; i < 4; ++i) {
                        auto rr = __builtin_amdgcn_permlane32_swap(__float_as_uint(va[i]), __float_as_uint(vb[i]), false, false);
                        va[i] = __uint_as_float(rr[0]); vb[i] = __uint_as_float(rr[1]);
                    }
                    const int dv0 = 32 * d + 16 * pr + 8 * hi;
                    const f32x4 gs0 = *(const f32x4*)(P->g_subln + dv0), gs1 = *(const f32x4*)(P->g_subln + dv0 + 4);
                    const u32x4 ga = *(const u32x4*)(GA + qrow_u + 32 * d + 16 * pr + eoff);
                    u32x4 w;
                    w.x = pk_bf16(va[0] * rstd * gs0[0] * bf_lo(ga.x), va[1] * rstd * gs0[1] * bf_hi(ga.x));
                    w.y = pk_bf16(va[2] * rstd * gs0[2] * bf_lo(ga.y), va[3] * rstd * gs0[3] * bf_hi(ga.y));
                    w.z = pk_bf16(vb[0] * rstd * gs1[0] * bf_lo(ga.z), vb[1] * rstd * gs1[1] * bf_hi(ga.z));
                    w.w = pk_bf16(vb[2] * rstd * gs1[2] * bf_lo(ga.w), vb[3] * rstd * gs1[3] * bf_hi(ga.w));
                    *(u32x4*)(ZOUT + qrow_u + 32 * d + 16 * pr + eoff) = w;
                    asm volatile("" ::: "memory");
                }
        }
    }
}

__device__ __forceinline__ void phase4(KP P, int wid, int lane) {
    const float* MODF = (const float*)(P->ws + WS_MODF);
    const bf16_t* Y = (const bf16_t*)(P->ws + WS_T);
    const float* PART = (const float*)(P->ws + WS_PART);
    const int gw = blockIdx.x * 8 + wid, NGW = gridDim.x * 8;
    f32x4 gp[4];
#pragma unroll
    for (int j = 0; j < 4; ++j) gp[j] = *(const f32x4*)(P->g_post + 4 * lane + 256 * j);
    for (int row = gw; row < ML; row += NGW) {
        const int b = row >> 11;
        float ss = PART[(size_t)row * 16 + (lane & 15)];
        ss += __shfl_xor(ss, 1); ss += __shfl_xor(ss, 2); ss += __shfl_xor(ss, 4); ss += __shfl_xor(ss, 8);
        const float rstd = rsqrtf(ss * (1.0f / 1024.0f) + NORM_EPS);
#pragma unroll
        for (int j = 0; j < 4; ++j) {
            const int c = 4 * lane + 256 * j;
            const f32x4 xv = *(const f32x4*)(P->x + (size_t)row * 1024 + c);
            const u32x2 yb = *(const u32x2*)(Y + (size_t)row * 1024 + c);
            const f32x4 yv = (f32x4){bf_lo(yb.x), bf_hi(yb.x), bf_lo(yb.y), bf_hi(yb.y)};
            const f32x4 gt = *(const f32x4*)(MODF + b * 3072 + 2048 + c);
            *(f32x4*)(P->out + (size_t)row * 1024 + c) = xv + gt * (yv * rstd * gp[j]);
        }
    }
}

#define XB_TMO      128
#define XB_XCNT(j)  (256  + 64 * (j))
#define XB_XSUB(j)  (1280 + 64 * (j))
#define XB_XGEN(j)  (2304 + 64 * (j))
#define XB_TOP      3328
#define XB_TOPGEN   3392
#define XCD_BAR_WORDS 3456
#define XB_SPIN_CAP (1u << 18)

__device__ __forceinline__ unsigned xb_ld(unsigned* p)              { return __hip_atomic_load(p, __ATOMIC_RELAXED, __HIP_MEMORY_SCOPE_AGENT); }
__device__ __forceinline__ unsigned xb_add(unsigned* p, unsigned v) { return __hip_atomic_fetch_add(p, v, __ATOMIC_RELAXED, __HIP_MEMORY_SCOPE_AGENT); }
__device__ __forceinline__ unsigned xb_xcc_id() { return (unsigned)__builtin_amdgcn_s_getreg((3 << 11) | 20) & 0xFu; }
#define XB_SPIN(cond, bar) do { unsigned _sp = 0; while (cond) { __builtin_amdgcn_s_sleep(1); \
    if ((++_sp & 255u) == 0u) { if (xb_ld(&(bar)[XB_TMO])) break; if (_sp > XB_SPIN_CAP) { atomicAdd(&(bar)[XB_TMO], 1u); break; } } } } while (0)

struct XcdBarrier {
    unsigned* bar; unsigned x;
    volatile LAS unsigned* st;
};

__device__ __forceinline__ XcdBarrier xcd_barrier_post(unsigned* bar, volatile LAS unsigned* st) {
    XcdBarrier b; b.bar = bar; b.x = xb_xcc_id(); b.st = st;
    if (threadIdx.x == 0) (void)xb_add(&bar[XB_XCNT(b.x)], 1u);
    return b;
}
__device__ __forceinline__ void xcd_barrier_complete(unsigned* bar, unsigned x, unsigned& nloc, unsigned& nx) {
    const unsigned G = gridDim.x * gridDim.y * gridDim.z;
    unsigned sum, cnt, mine, sp = 0u;
    for (;;) {
        sum = 0u; cnt = 0u; mine = 0u;
#pragma unroll
        for (unsigned j = 0; j < 16; ++j) { const unsigned c = xb_ld(&bar[XB_XCNT(j)]); sum += c; cnt += (c > 0u) ? 1u : 0u; mine = (j == x) ? c : mine; }
        if (sum == G) break;
        __builtin_amdgcn_s_sleep(1);
        if ((++sp & 255u) == 0u) { if (xb_ld(&bar[XB_TMO])) break; if (sp > XB_SPIN_CAP) { atomicAdd(&bar[XB_TMO], 1u); break; } }
    }
    nloc = mine > 0u ? mine : 1u; nx = cnt > 0u ? cnt : 1u;
}

__device__ __forceinline__ void xcd_barrier(const XcdBarrier& b) {
    asm volatile("s_waitcnt vmcnt(0)" ::: "memory");
    __syncthreads();
    if (threadIdx.x == 0) {
        unsigned* bar = b.bar;
        __builtin_amdgcn_s_waitcnt(0);
        unsigned nloc = b.st[0], nx = b.st[1];
        if (nloc == 0u) { xcd_barrier_complete(bar, b.x, nloc, nx); b.st[0] = nloc; b.st[1] = nx; }
        const unsigned old = xb_add(&bar[XB_XSUB(b.x)], 1u);
        const unsigned gen = old / nloc;
        if (old + 1u == (gen + 1u) * nloc) {
            __builtin_amdgcn_fence(__ATOMIC_RELEASE, "agent");
            asm volatile("s_waitcnt vmcnt(0)" ::: "memory");
            const unsigned og = xb_add(&bar[XB_TOP], 1u);
            const unsigned tg = og / nx;
            if (og + 1u == (tg + 1u) * nx) xb_add(&bar[XB_TOPGEN], 1u);
            else XB_SPIN(xb_ld(&bar[XB_TOPGEN]) == tg, bar);
            __builtin_amdgcn_fence(__ATOMIC_ACQUIRE, "agent");
            xb_add(&bar[XB_XGEN(b.x)], 1u);
            asm volatile("s_waitcnt vmcnt(0)" ::: "memory");
        } else {
            XB_SPIN(xb_ld(&bar[XB_XGEN(b.x)]) == gen, bar);
            __builtin_amdgcn_fence(__ATOMIC_ACQUIRE, "agent");
            asm volatile("s_waitcnt vmcnt(0)" ::: "memory");
        }
    }
    __syncthreads();
}

__global__ void __launch_bounds__(512, 2) hybrid_fwd(Params Pval) {
    KP P = (KP)__builtin_amdgcn_kernarg_segment_ptr();
    extern __shared__ __attribute__((aligned(16))) unsigned char lds[];
    cg::grid_group grid = cg::this_grid();
#define FRESH_TID() int tid = threadIdx.x; asm volatile("" : "+v"(tid)); const int lane = tid & 63, wid = __builtin_amdgcn_readfirstlane(tid >> 6)
    const int G = gridDim.x, bx = blockIdx.x;
    unsigned char* ws = P->ws;
    if (threadIdx.x < 2) ((volatile LAS unsigned*)((LAS unsigned char*)lds + LDS_BARW))[threadIdx.x] = 0u;
    if (bx == 0) for (int i = threadIdx.x; i < (int)(WS_BAR_BYTES / 4); i += 512) __hip_atomic_store((unsigned*)(ws + WS_BAR) + i, 0u, __ATOMIC_RELAXED, __HIP_MEMORY_SCOPE_AGENT);
    __syncthreads();
    LAS unsigned char* ldsl = (LAS unsigned char*)lds;

#ifndef NO_P0A
    { FRESH_TID(); phase0a(P, lds, tid, wid, lane); }
#endif
    grid.sync();
    const XcdBarrier xbar = xcd_barrier_post((unsigned*)(ws + WS_BAR), (volatile LAS unsigned*)((LAS unsigned char*)lds + LDS_BARW));
#ifndef NO_P0B
    { FRESH_TID(); (void)tid; phase0b(P, wid, lane); }
#endif
    xcd_barrier(xbar);
#ifndef NO_P1
    {
        pg8::Gemm g{(const bf16_t*)(ws + WS_XN), (const bf16_t*)(ws + WS_WIN), MALL, NIN, 1024};
        InProjOrder S; S.init(G, bx);
        EpiInProj E{(bf16_t*)(ws + WS_Q), (bf16_t*)(ws + WS_KA), (bf16_t*)(ws + WS_VA), (bf16_t*)(ws + WS_GA), (bf16_t*)(ws + WS_XR), (bf16_t*)(ws + WS_GR), (bf16_t*)P->out,
                    (const f32x2*)(ws + WS_ROPE)};
        pg8::gemm_phase<EpiInProj, InProjOrder, true, true>(ldsl, g, S, E);
    }
#endif
    xcd_barrier(xbar);
    {
        const int vcu = (G % 8 == 0) ? (bx % 8) * (G / 8) + bx / 8 : bx;
#ifndef NO_LRU
        { FRESH_TID(); for (int u = vcu; u < 256; u += G) lru_unit(P, lds, (bf16_t*)(ws + WS_GR), u >> 4, u & 15, tid, wid, lane); }
#endif
#ifndef NO_ATT
        { FRESH_TID();
          float s1 = P->lq1[lane] * P->lk1[lane], s2 = P->lq2[lane] * P->lk2[lane];
          s1 = wave_sum(s1); s2 = wave_sum(s2);
          const float lam = __expf(s1) - __expf(s2) + LAM_INIT;
          for (int u = vcu; u < 1024; u += G) { const int bh = u >> 3; attn_unit(P, lds, (bf16_t*)(ws + WS_Q), bh >> 3, bh & 7, u & 7, lam, tid, wid, lane); } }
#endif
    }
    xcd_barrier(xbar);
#ifndef NO_P3A
    {
        PairOrder S; S.init(G, bx);
        pg8::Gemm g{(const bf16_t*)(ws + WS_Q), (const bf16_t*)(ws + WS_WA), 2 * ML, 2048, 1024};
        static_assert(WS_GR - WS_Q == (size_t)ML * 1024 * 2 && WS_WL - WS_WA == (size_t)1024 * 1024 * 2, "the second merge GEMM's operands must sit one full matrix behind the first's");
        EpiMerge E{(const bf16_t*)P->out, (bf16_t*)(ws + WS_XN)};
        pg8::gemm_phase<EpiMerge, PairOrder, true, true>(ldsl, g, S, E);
    }
#endif
    xcd_barrier(xbar);
#ifndef NO_P3B
    {
        pg8::StaticOrder S; S.init(ML, 1024, G, bx);
        pg8::Gemm g{(const bf16_t*)(ws + WS_XN), (const bf16_t*)(ws + WS_WO), ML, 1024, 1024};
        EpiOut E{(bf16_t*)(ws + WS_T), (float*)(ws + WS_PART)};
        pg8::gemm_phase<EpiOut, pg8::StaticOrder, true, true>(ldsl, g, S, E);
    }
#endif
    xcd_barrier(xbar);
#ifndef NO_P4
    { FRESH_TID(); (void)tid; phase4(P, wid, lane); }
#endif
}

extern "C" void kernel_launch(void* const* d_in, const int* in_sizes, int n_in, void* d_out, int out_size, void* d_ws, size_t ws_size, hipStream_t stream) {
    static int grid_blocks = 0;
    if (grid_blocks == 0) {
        if (n_in != 24 || out_size != ML * DM || ws_size < WS_END) { fprintf(stderr, "kernel_launch: unexpected problem (n_in %d out %d ws %zu)\n", n_in, out_size, ws_size); grid_blocks = -1; return; }
        int dev = 0, cus = 0, per_cu = 0;
        hipGetDevice(&dev);
        hipDeviceGetAttribute(&cus, hipDeviceAttributeMultiprocessorCount, dev);
        if (hipFuncSetAttribute((const void*)hybrid_fwd, hipFuncAttributeMaxDynamicSharedMemorySize, LDS_BYTES) != hipSuccess) { fprintf(stderr, "kernel_launch: hipFuncSetAttribute failed\n"); grid_blocks = -1; return; }
        if (hipOccupancyMaxActiveBlocksPerMultiprocessor(&per_cu, (const void*)hybrid_fwd, 512, LDS_BYTES) != hipSuccess || per_cu < 1) { fprintf(stderr, "kernel_launch: occupancy query failed (%d)\n", per_cu); (void)hipGetLastError(); per_cu = 1; }
        grid_blocks = cus;
        fprintf(stderr, "kernel_launch: cus %d per_cu %d grid %d\n", cus, per_cu, grid_blocks);
    }
    if (grid_blocks < 0) return;
    Params p{};
    const float** pf = (const float**)&p;
    for (int i = 0; i < 24; ++i) pf[i] = (const float*)d_in[i];
    p.out = (float*)d_out; p.ws = (unsigned char*)d_ws;
    void* args[] = {&p};
    hipError_t e = hipLaunchCooperativeKernel((const void*)hybrid_fwd, dim3(grid_blocks), dim3(512), args, LDS_BYTES, stream);
    if (e != hipSuccess) fprintf(stderr, "kernel_launch: cooperative launch failed: %s (grid %d)\n", hipGetErrorString(e), grid_blocks);
}
```

```cpp
#include <hip/hip_runtime.h>
#include <hip/hip_cooperative_groups.h>
#include <cstdio>
#include <cstdint>
namespace cg = cooperative_groups;
namespace pg8 {
#define PG8_LAS __attribute__((address_space(3)))
typedef unsigned short bf16_t;
typedef short bf16x8 __attribute__((ext_vector_type(8)));
typedef float f32x4 __attribute__((ext_vector_type(4)));
typedef unsigned u32x4 __attribute__((ext_vector_type(4)));
constexpr int BM = 256, BK = 64, HALF = 128, HTB = HALF * BK * 2  , STAGE_BYTES = 8 * HTB, NXCD = 8, WGM = 8;

__host__ __device__ __forceinline__ int lds_byte(int r, int c) { const int st = (r >> 4) * 2 + (c >> 5), rr = r & 15, cc = c & 31, ob = rr * 64 + cc * 2; return st * 1024 + (ob ^ (((ob >> 9) & 1) << 5)); }
__host__ __device__ __forceinline__ void stage_rc(int b, int& R, int& C) { const int st = b / 1024, sb = b % 1024, swz = sb ^ (((sb >> 9) & 1) << 5); R = (st >> 1) * 16 + swz / 64; C = (st & 1) * 32 + (swz % 64) / 2; }
__host__ __device__ __forceinline__ int perm32(int rho) { const int n = rho >> 4, i = rho & 15; return 8 * (i >> 2) + 4 * n + (i & 3); }

struct Unit { int pm, pn; };
struct Gemm { const bf16_t* A; const bf16_t* Bt; int M, N, K; };

struct StaticOrder {
    int nM, nN, nwg, G, c;
    __host__ __device__ void init(int M, int N, int G_, int c_) { nM = M / BM; nN = N / BM; nwg = nM * nN; G = G_; c = c_; }
    __host__ __device__ bool next(int i, Unit& u) const {
        const long L = (long)i * G + c; if (L >= nwg) return false;
        int wgid = (int)L; { const int q = nwg / NXCD, r = nwg % NXCD, xcd = wgid % NXCD, off = wgid / NXCD; wgid = (xcd < r ? xcd * (q + 1) : r * (q + 1) + (xcd - r) * q) + off; }
        const int nig = WGM * nN, gid = wgid / nig, fm = gid * WGM, gsz = (nM - fm) < WGM ? (nM - fm) : WGM;
        u.pm = fm + ((wgid % nig) % gsz); u.pn = (wgid % nig) / gsz; return true;
    }
    __device__ __forceinline__ void a_ready(const Unit&) const {}
    __device__ __forceinline__ void done(const Unit&) const {}
};

__device__ __forceinline__ unsigned cvt_pk_bf16(float lo, float hi) { unsigned r; asm volatile("v_cvt_pk_bf16_f32 %0, %1, %2" : "=v"(r) : "v"(lo), "v"(hi)); return r; }
typedef float f32x2 __attribute__((ext_vector_type(2)));
template <class Epi, class Sched, bool ALIGN_EPI = false, bool SP2 = false>
__device__ __forceinline__ void gemm_phase(PG8_LAS unsigned char* lds, const Gemm g, const Sched& S, const Epi& E) {
    int tid_ = threadIdx.x; asm volatile("" : "+v"(tid_));
    const int tid = tid_, wid = __builtin_amdgcn_readfirstlane(tid >> 6), lane = tid & 63, wr = wid >> 2, wc = wid & 3, fr = lane & 15, fq = lane >> 4;
    const int K = g.K, nt = K / BK;
    unsigned voffA[2], voffB[2];
#pragma unroll
    for (int i = 0; i < 2; ++i) { int R, C; stage_rc(tid * 16 + i * 8192, R, C); const int Rb = Epi::PERM ? ((R & ~31) + perm32(R & 31)) : R;
        voffA[i] = (unsigned)(R * K + C) * 2u; voffB[i] = (unsigned)(Rb * K + C) * 2u; }
    const size_t kstep = (size_t)(BK * 2);
    const size_t hstep = (size_t)HALF * K * 2;
    const size_t tstep = 2 * hstep;
    const unsigned ldsw = (unsigned)wid * 1024u;
    const int aoff = lds_byte(wr * 64 + fr, fq * 8), boff = lds_byte(wc * 32 + fr, fq * 8);
#define PG8_SA(b, h) (((b) * 2 + (h)) * HTB)
#define PG8_SB(b, h) ((4 + (b) * 2 + (h)) * HTB)
#define PG8_STAGE(bufoff, gbase, voff) do { _Pragma("unroll") for (int _i = 0; _i < 2; ++_i) \
        __builtin_amdgcn_global_load_lds((const unsigned*)((const char*)(gbase) + (voff)[_i]), (PG8_LAS unsigned*)(lds + (bufoff) + ldsw + _i * 8192), 16, 0, 0); } while (0)
#define PG8_LDA(dst, b, h) do { _Pragma("unroll") for (int m = 0; m < 4; ++m) _Pragma("unroll") for (int k = 0; k < 2; ++k) dst[m][k] = *(const PG8_LAS bf16x8*)(lds + PG8_SA(b, h) + aoff + m * 2048 + k * 1024); } while (0)
#define PG8_LDB(dst, b, h) do { _Pragma("unroll") for (int n = 0; n < 2; ++n) _Pragma("unroll") for (int k = 0; k < 2; ++k) dst[n][k] = *(const PG8_LAS bf16x8*)(lds + PG8_SB(b, h) + boff + n * 2048 + k * 1024); } while (0)
#define PG8_MMA(ai, bj, At, Bt) do { __builtin_amdgcn_s_setprio(1); _Pragma("unroll") for (int m = 0; m < 4; ++m) _Pragma("unroll") for (int n = 0; n < 2; ++n) _Pragma("unroll") for (int k = 0; k < 2; ++k) \
        acc[ai][bj][m][n] = __builtin_amdgcn_mfma_f32_16x16x32_bf16(Bt[n][k], At[m][k], acc[ai][bj][m][n], 0, 0, 0); __builtin_amdgcn_s_setprio(0); } while (0)
#define PG8_WAIT_V(n) asm volatile("s_waitcnt vmcnt(" #n ")" ::: "memory")
#define PG8_WAIT_L(n) asm volatile("s_waitcnt lgkmcnt(" #n ")" ::: "memory")
#define PG8_BAR __builtin_amdgcn_s_barrier()
#define PG8_SCHED __builtin_amdgcn_sched_barrier(0)
    Unit cur, nxt; int ui = 0;
    if (!S.next(0, cur)) return;
    f32x4 acc[2][2][4][2];
#pragma unroll
    for (int a = 0; a < 2; ++a)
#pragma unroll
        for (int b = 0; b < 2; ++b)
#pragma unroll
            for (int m = 0; m < 4; ++m)
#pragma unroll
                for (int n = 0; n < 2; ++n) acc[a][b][m][n] = (f32x4){0.f, 0.f, 0.f, 0.f};
    bf16x8 At[4][2], B0[2][2], B1[2][2];
    const char* cA = (const char*)g.A + (size_t)cur.pm * tstep; const char* cB = (const char*)g.Bt + (size_t)cur.pn * tstep;
    S.a_ready(cur);
    if constexpr (SP2) {
        PG8_STAGE(PG8_SB(0, 0), cB, voffB); PG8_STAGE(PG8_SB(0, 1), cB + hstep, voffB); PG8_STAGE(PG8_SA(0, 0), cA, voffA); PG8_STAGE(PG8_SA(0, 1), cA + hstep, voffA);
        if (wr == 1) PG8_BAR;
        PG8_WAIT_V(2); PG8_BAR;
        PG8_STAGE(PG8_SB(1, 0), cB + kstep, voffB); PG8_STAGE(PG8_SA(1, 0), cA + kstep, voffA); PG8_STAGE(PG8_SB(1, 1), cB + hstep + kstep, voffB);
        PG8_WAIT_V(6); PG8_BAR;
    } else {
        PG8_STAGE(PG8_SB(0, 0), cB, voffB); PG8_STAGE(PG8_SA(0, 0), cA, voffA); PG8_STAGE(PG8_SB(0, 1), cB + hstep, voffB); PG8_STAGE(PG8_SA(0, 1), cA + hstep, voffA);
        if (wr == 1) PG8_BAR;
        PG8_WAIT_V(4); PG8_BAR;
        PG8_STAGE(PG8_SB(1, 0), cB + kstep, voffB); PG8_STAGE(PG8_SA(1, 0), cA + kstep, voffA); PG8_STAGE(PG8_SB(1, 1), cB + hstep + kstep, voffB);
        PG8_WAIT_V(6); PG8_BAR;
    }
    for (;;) {
        const bool has_next = S.next(ui + 1, nxt);
        const char* nA = has_next ? (const char*)g.A + (size_t)nxt.pm * tstep : cA; const char* nB = has_next ? (const char*)g.Bt + (size_t)nxt.pn * tstep : cB;
        for (int t = 0; t < nt; t += 2) {
            const bool last = (t == nt - 2);
            const char* a1 = cA + (size_t)(t + 1) * kstep;
            const char* a2 = last ? nA : cA + (size_t)(t + 2) * kstep; const char* b2 = last ? nB : cB + (size_t)(t + 2) * kstep;
            const char* a3 = a2 + kstep; const char* b3 = b2 + kstep;
            if (last && has_next) S.a_ready(nxt);
            if constexpr (SP2) {
            PG8_LDB(B0, 0, 0); PG8_LDB(B1, 0, 1); PG8_SCHED; PG8_LDA(At, 0, 0); PG8_STAGE(PG8_SA(1, 1), a1 + hstep, voffA);
            PG8_WAIT_V(8); PG8_WAIT_L(0); PG8_BAR; PG8_MMA(0, 0, At, B0); PG8_MMA(0, 1, At, B1); PG8_BAR; PG8_SCHED;
            PG8_LDA(At, 0, 1); PG8_STAGE(PG8_SB(0, 0), b2, voffB); PG8_STAGE(PG8_SB(0, 1), b2 + hstep, voffB); PG8_STAGE(PG8_SA(0, 0), a2, voffA);
            PG8_WAIT_V(8); PG8_WAIT_L(0); PG8_BAR; PG8_MMA(1, 0, At, B0); PG8_MMA(1, 1, At, B1); PG8_BAR; PG8_SCHED;
            PG8_LDB(B0, 1, 0); PG8_LDB(B1, 1, 1); PG8_SCHED; PG8_LDA(At, 1, 0); PG8_STAGE(PG8_SA(0, 1), a2 + hstep, voffA);
            PG8_WAIT_V(8); PG8_WAIT_L(0); PG8_BAR; PG8_MMA(0, 0, At, B0); PG8_MMA(0, 1, At, B1); PG8_BAR; PG8_SCHED;
            PG8_LDA(At, 1, 1); PG8_STAGE(PG8_SB(1, 0), b3, voffB); PG8_STAGE(PG8_SB(1, 1), b3 + hstep, voffB); PG8_STAGE(PG8_SA(1, 0), a3, voffA);
            PG8_WAIT_V(8); PG8_WAIT_L(0); PG8_BAR; PG8_MMA(1, 0, At, B0); PG8_MMA(1, 1, At, B1); PG8_BAR; PG8_SCHED;
            } else {
            PG8_LDB(B0, 0, 0); PG8_SCHED; PG8_LDA(At, 0, 0); PG8_STAGE(PG8_SA(1, 1), a1 + hstep, voffA);
            PG8_WAIT_L(8); PG8_BAR; PG8_WAIT_L(0); PG8_MMA(0, 0, At, B0); PG8_BAR; PG8_SCHED;
            PG8_LDB(B1, 0, 1); PG8_STAGE(PG8_SB(0, 0), b2, voffB);
            PG8_BAR; PG8_WAIT_L(0); PG8_MMA(0, 1, At, B1); PG8_BAR;
            PG8_LDA(At, 0, 1); PG8_STAGE(PG8_SA(0, 0), a2, voffA);
            PG8_BAR; PG8_WAIT_L(0); PG8_MMA(1, 0, At, B0); PG8_BAR; PG8_SCHED;
            PG8_STAGE(PG8_SB(0, 1), b2 + hstep, voffB);
            PG8_WAIT_V(6); PG8_BAR; PG8_MMA(1, 1, At, B1); PG8_BAR;
            PG8_LDB(B0, 1, 0); PG8_SCHED; PG8_LDA(At, 1, 0); PG8_STAGE(PG8_SA(0, 1), a2 + hstep, voffA);
            PG8_WAIT_L(8); PG8_BAR; PG8_WAIT_L(0); PG8_MMA(0, 0, At, B0); PG8_BAR; PG8_SCHED;
            PG8_LDB(B1, 1, 1); PG8_STAGE(PG8_SB(1, 0), b3, voffB);
            PG8_BAR; PG8_WAIT_L(0); PG8_MMA(0, 1, At, B1); PG8_BAR;
            PG8_LDA(At, 1, 1); PG8_STAGE(PG8_SA(1, 0), a3, voffA);
            PG8_BAR; PG8_WAIT_L(0); PG8_MMA(1, 0, At, B0); PG8_BAR; PG8_SCHED;
            PG8_STAGE(PG8_SB(1, 1), b3 + hstep, voffB);
            PG8_WAIT_V(6); PG8_BAR; PG8_MMA(1, 1, At, B1); PG8_BAR;
            }
        }
        if constexpr (ALIGN_EPI) { if (wr == 0) PG8_BAR; }
        if constexpr (!Epi::AFTER_DRAIN) { E(acc, cur, wr, wc, fr, fq); S.done(cur); }
        if (!has_next) break;
        if (!E.chain(cur)) {
#pragma unroll
        for (int a = 0; a < 2; ++a)
#pragma unroll
            for (int b = 0; b < 2; ++b)
#pragma unroll
                for (int m = 0; m < 4; ++m)
#pragma unroll
                    for (int n = 0; n < 2; ++n) acc[a][b][m][n] = (f32x4){0.f, 0.f, 0.f, 0.f};
        }
        cur = nxt; cA = nA; cB = nB; ++ui;
        if constexpr (ALIGN_EPI) { if (wr == 1) PG8_BAR; }
    }
    PG8_WAIT_V(0);
    if constexpr (!ALIGN_EPI) { if (wr == 0) PG8_BAR; }
    PG8_BAR;
    if constexpr (Epi::AFTER_DRAIN) { E.fused(acc, cur, wr, wc, fr, fq, lds, wid, lane); S.done(cur); }
#undef PG8_SA
#undef PG8_SB
#undef PG8_STAGE
#undef PG8_LDA
#undef PG8_LDB
#undef PG8_MMA
#undef PG8_WAIT_V
#undef PG8_WAIT_L
#undef PG8_BAR
#undef PG8_SCHED
}
}

constexpr int NB = 16, SEQ = 2048, DM = 1024, CTXL = 256, LALL = SEQ + CTXL;
constexpr int ML = NB * SEQ, MC = NB * CTXL, MALL = ML + MC;
constexpr int NIN = 8192, NHEAD = 8;
constexpr float NORM_EPS = 1e-6f;
constexpr float LAM_INIT = 0.2f;

#define LAS __attribute__((address_space(3)))
typedef pg8::bf16_t bf16_t;
typedef pg8::bf16x8 bf16x8;
typedef pg8::f32x4 f32x4;
typedef pg8::u32x4 u32x4;
typedef float f32x16 __attribute__((ext_vector_type(16)));
typedef float f32x2 __attribute__((ext_vector_type(2)));
typedef unsigned u32x2 __attribute__((ext_vector_type(2)));
typedef short s16x4 __attribute__((ext_vector_type(4)));
typedef __bf16 bf16x2_t __attribute__((ext_vector_type(2)));

constexpr size_t MiB = 1u << 20;
constexpr size_t WS_MODF = 0;
constexpr size_t WS_ROPE = 256 * 1024;
constexpr size_t WS_BAR = 1 * MiB, WS_BAR_BYTES = 16384;
constexpr int LDS_BARW = 131072 + 64;
constexpr size_t WS_WIN = 2 * MiB;
constexpr size_t WS_WA = 18 * MiB, WS_WL = 20 * MiB, WS_WO = 22 * MiB;
constexpr size_t WS_XN = 24 * MiB;
constexpr size_t WS_Q = 96 * MiB;
constexpr size_t WS_GR = 160 * MiB;
constexpr size_t WS_GA = 224 * MiB;
constexpr size_t WS_KA = 288 * MiB;
constexpr size_t WS_VA = 360 * MiB;
constexpr size_t WS_T = 288 * MiB;
constexpr size_t WS_XR = 432 * MiB;
constexpr size_t WS_PART = 504 * MiB;
constexpr size_t WS_END = 506 * MiB;

constexpr int LDS_BYTES = 147456;

__device__ __forceinline__ unsigned pk_bf16(float lo, float hi) { f32x2 v = {lo, hi}; bf16x2_t b = __builtin_convertvector(v, bf16x2_t); return __builtin_bit_cast(unsigned, b); }
__device__ __forceinline__ float bf_lo(unsigned u) { return __uint_as_float(u << 16); }
__device__ __forceinline__ float bf_hi(unsigned u) { return __uint_as_float(u & 0xffff0000u); }
__device__ __forceinline__ float sigmoidf_(float v) { return __builtin_amdgcn_rcpf(1.0f + __builtin_amdgcn_exp2f(-1.4426950408889634f * v)); }
__device__ __forceinline__ float siluf_(float v) { return v * sigmoidf_(v); }
#define LDS_BARRIER() do { asm volatile("s_waitcnt lgkmcnt(0)" ::: "memory"); __builtin_amdgcn_s_barrier(); asm volatile("" ::: "memory"); } while (0)

struct InProjOrder {
    pg8::StaticOrder S; int G, c;
    __device__ void init(int G_, int c_) { S.init(ML, NIN, G_, c_); G = G_; c = c_; }
    __device__ bool next(int i, pg8::Unit& u) const {
        const long L = (long)i * G + c;
        if (L < 4096) return S.next(i, u);
        const int j = (int)(L - 4096); if (j >= 192) return false;
        u.pm = 128 + (j & 15); const int q = j >> 4; u.pn = q < 8 ? 4 + q : 8 + q;
        return true;
    }
    __device__ __forceinline__ void a_ready(const pg8::Unit&) const {}
    __device__ __forceinline__ void done(const pg8::Unit&) const {}
};

struct EpiInProj {
    static constexpr bool PERM = true, AFTER_DRAIN = false;
    __device__ __forceinline__ bool chain(const pg8::Unit&) const { return false; }
    bf16_t *Q, *KA, *VA, *GA, *XR, *GR, *GM; const f32x2* rope;
    __device__ __forceinline__ void operator()(const f32x4 (&acc)[2][2][4][2], const pg8::Unit& u, int wr, int wc, int fr, int fq) const {
        const int pn = u.pn, pm = u.pm;
        const bool lat = pm < 128;
        const int b = lat ? (pm >> 3) : (pm - 128);
        const int tb = lat ? ((pm & 7) << 8) : 0;
        const int seg = pn >> 2;
        bf16_t* base; int pitch = 1024; size_t row0; int col0 = (pn & 3) * 256; int mode = 0;
        const size_t rowL = (size_t)b * SEQ + tb, rowA = (size_t)b * LALL + (lat ? CTXL : 0) + tb;
        float qs = 1.0f;
        if (seg == 0) { base = Q; row0 = rowL; mode = 1; qs = 0.125f * 1.4426950408889634f; }
        else if (seg == 1) { base = KA; row0 = rowA; mode = lat ? 1 : 0; }
        else if (seg == 2) { base = VA; row0 = rowA; }
        else if (seg == 3) { base = GA; row0 = rowL; mode = 2; }
        else if (seg == 4) { base = XR; row0 = rowA; }
        else if (seg == 5) { base = GR; row0 = rowL; mode = 2; }
        else { base = GM; pitch = 2048; row0 = rowL; col0 = (pn - 24) * 256; mode = 3; }
        const int lcol = wc * 32 + 8 * fq;
        const float sgn = (fq & 2) ? 1.0f : -1.0f;
#pragma unroll
        for (int ai = 0; ai < 2; ++ai)
#pragma unroll
            for (int m = 0; m < 4; ++m) {
                const int rloc = ai * 128 + wr * 64 + m * 16 + fr;
                bf16_t* rowp = base + (row0 + rloc) * (size_t)pitch + col0 + lcol;
                const int pos = (wc & 1) ? (m * 16 + fr) : ((tb >> 6) + 2 * ai + wr);
                const f32x4* rp = (const f32x4*)(rope + pos * 16 + 8 * (fq & 1));
#pragma unroll
                for (int bj = 0; bj < 2; ++bj) {
                    f32x4 v[2] = {acc[ai][bj][m][0], acc[ai][bj][m][1]};
                    if (mode == 1) {
#pragma unroll
                        for (int n = 0; n < 2; ++n) {
                            f32x4 p;
#pragma unroll
                            for (int i = 0; i < 4; ++i) p[i] = __shfl_xor(v[n][i], 32);
                            const f32x4 c0 = rp[2 * n], c1 = rp[2 * n + 1];
                            v[n][0] = (v[n][0] * c0[0] + sgn * p[0] * c0[1]) * qs;
                            v[n][1] = (v[n][1] * c0[2] + sgn * p[1] * c0[3]) * qs;
                            v[n][2] = (v[n][2] * c1[0] + sgn * p[2] * c1[1]) * qs;
                            v[n][3] = (v[n][3] * c1[2] + sgn * p[3] * c1[3]) * qs;
                            asm volatile("" ::: "memory");
                        }
                    } else if (mode == 2) {
#pragma unroll
                        for (int n = 0; n < 2; ++n)
#pragma unroll
                            for (int i = 0; i < 4; ++i) v[n][i] = siluf_(v[n][i]);
                    } else if (mode == 3) {
#pragma unroll
                        for (int n = 0; n < 2; ++n)
#pragma unroll
                            for (int i = 0; i < 4; ++i) v[n][i] = sigmoidf_(v[n][i]);
                    }
                    u32x4 w; w.x = pk_bf16(v[0][0], v[0][1]); w.y = pk_bf16(v[0][2], v[0][3]); w.z = pk_bf16(v[1][0], v[1][1]); w.w = pk_bf16(v[1][2], v[1][3]);
                    *(u32x4*)(rowp + bj * 128) = w;
                }
                asm volatile("" ::: "memory");
            }
    }
};

struct PairOrder {
    pg8::StaticOrder S;
    __device__ void init(int G_, int c_) { S.init(ML, 1024, G_, c_); }
    __device__ bool next(int i, pg8::Unit& u) const { if (!S.next(i >> 1, u)) return false; if (i & 1) { u.pm += 128; u.pn += 4; } return true; }
    __device__ __forceinline__ void a_ready(const pg8::Unit&) const {}
    __device__ __forceinline__ void done(const pg8::Unit&) const {}
};
struct EpiMerge {
    static constexpr bool PERM = true, AFTER_DRAIN = false;
    const bf16_t* GM; bf16_t* MB;
    __device__ __forceinline__ bool chain(const pg8::Unit& u) const { return u.pm < 128; }
    __device__ __forceinline__ void operator()(f32x4 (&acc)[2][2][4][2], const pg8::Unit& u, int wr, int wc, int fr, int fq) const {
        const bool first = u.pm < 128;
        const int pm = first ? u.pm : u.pm - 128, pn = first ? u.pn : u.pn - 4;
#pragma unroll
        for (int ai = 0; ai < 2; ++ai)
#pragma unroll
            for (int m = 0; m < 4; ++m) {
                const size_t row = (size_t)pm * 256 + ai * 128 + wr * 64 + m * 16 + fr;
#pragma unroll
                for (int bj = 0; bj < 2; ++bj) {
                    const int col = pn * 256 + bj * 128 + wc * 32 + 8 * fq;
                    const u32x4 gl = *(const u32x4*)(GM + row * 2048 + 1024 + col);
                    float ml[8] = {bf_lo(gl.x), bf_hi(gl.x), bf_lo(gl.y), bf_hi(gl.y), bf_lo(gl.z), bf_hi(gl.z), bf_lo(gl.w), bf_hi(gl.w)};
                    if (first) {
                        const u32x4 ga = *(const u32x4*)(GM + row * 2048 + col);
                        const float ma[8] = {bf_lo(ga.x), bf_hi(ga.x), bf_lo(ga.y), bf_hi(ga.y), bf_lo(ga.z), bf_hi(ga.z), bf_lo(ga.w), bf_hi(ga.w)};
#pragma unroll
                        for (int i = 0; i < 4; ++i) { acc[ai][bj][m][0][i] *= ma[i] * __builtin_amdgcn_rcpf(fmaxf(ml[i], 1e-30f)); acc[ai][bj][m][1][i] *= ma[4 + i] * __builtin_amdgcn_rcpf(fmaxf(ml[4 + i], 1e-30f)); }
                    } else {
                        const f32x4 a0 = acc[ai][bj][m][0], a1 = acc[ai][bj][m][1];
                        u32x4 w; w.x = pk_bf16(a0[0] * ml[0], a0[1] * ml[1]); w.y = pk_bf16(a0[2] * ml[2], a0[3] * ml[3]); w.z = pk_bf16(a1[0] * ml[4], a1[1] * ml[5]); w.w = pk_bf16(a1[2] * ml[6], a1[3] * ml[7]);
                        *(u32x4*)(MB + row * 1024 + col) = w;
                    }
                }
                asm volatile("" ::: "memory");
            }
    }
};
struct EpiOut {
    static constexpr bool PERM = true, AFTER_DRAIN = false;
    __device__ __forceinline__ bool chain(const pg8::Unit&) const { return false; }
    bf16_t* Y; float* PART;
    __device__ __forceinline__ void operator()(const f32x4 (&acc)[2][2][4][2], const pg8::Unit& u, int wr, int wc, int fr, int fq) const {
#pragma unroll
        for (int ai = 0; ai < 2; ++ai)
#pragma unroll
            for (int m = 0; m < 4; ++m) {
                const size_t row = (size_t)u.pm * 256 + ai * 128 + wr * 64 + m * 16 + fr;
                float ss = 0.f;
#pragma unroll
                for (int bj = 0; bj < 2; ++bj) {
                    const int col = u.pn * 256 + bj * 128 + wc * 32 + 8 * fq;
                    const f32x4 a0 = acc[ai][bj][m][0], a1 = acc[ai][bj][m][1];
                    u32x4 w; w.x = pk_bf16(a0[0], a0[1]); w.y = pk_bf16(a0[2], a0[3]); w.z = pk_bf16(a1[0], a1[1]); w.w = pk_bf16(a1[2], a1[3]);
                    *(u32x4*)(Y + row * 1024 + col) = w;
                    ss += (a0[0] * a0[0] + a0[1] * a0[1]) + (a0[2] * a0[2] + a0[3] * a0[3]) + (a1[0] * a1[0] + a1[1] * a1[1]) + (a1[2] * a1[2] + a1[3] * a1[3]);
                }
                ss += __shfl_xor(ss, 16); ss += __shfl_xor(ss, 32);
                if (fq == 0) PART[row * 16 + u.pn * 4 + wc] = ss;
            }
    }
};

struct Params {
    const float *x, *c, *ctx, *c_ctx, *w_mod, *b_mod, *g_pre, *g_post, *w_in, *lq1, *lk1, *lq2, *lk2, *g_subln, *w_attn_out, *conv_w, *conv_b,
                *w_rg_a, *b_rg_a, *w_rg_x, *b_rg_x, *lru_lambda, *w_lru_out, *w_out;
    float* out; unsigned char* ws;
};

typedef const __attribute__((address_space(4))) Params* KP;

__device__ __forceinline__ float wave_sum(float v) {
#pragma unroll
    for (int o = 1; o < 64; o <<= 1) v += __shfl_xor(v, o);
    return v;
}

__device__ __forceinline__ void transpose_item(const float* W, int K, int N, bf16_t* WT, LAS float* scr, int item, int lane) {
    const int nblk = N / 32, kb = item / nblk, nb = item % nblk, k0 = 64 * kb, n0 = 32 * nb;
#pragma unroll 8
    for (int i = 0; i < 32; ++i) { const int kk = 2 * i + (lane >> 5); scr[kk * 33 + (lane & 31)] = W[(size_t)(k0 + kk) * N + n0 + (lane & 31)]; }
    asm volatile("s_waitcnt lgkmcnt(0)" ::: "memory");
    const int c = lane & 7;
#pragma unroll
    for (int j = 0; j < 4; ++j) { const int n = (lane >> 3) + 8 * j; const LAS float* s = scr + (8 * c) * 33 + n;
        u32x4 o; o.x = pk_bf16(s[0 * 33], s[1 * 33]); o.y = pk_bf16(s[2 * 33], s[3 * 33]); o.z = pk_bf16(s[4 * 33], s[5 * 33]); o.w = pk_bf16(s[6 * 33], s[7 * 33]);
        *(u32x4*)(WT + (size_t)(n0 + n) * K + k0 + 8 * c) = o; }
    asm volatile("s_waitcnt lgkmcnt(0)" ::: "memory");
}

__device__ __forceinline__ void phase0a(KP P, unsigned char* lds, int tid, int wid, int lane) {
    unsigned char* ws = P->ws;
    const int G = gridDim.x, bx = blockIdx.x;
    for (int item = bx; item < 192; item += G) {
        float* s = (float*)lds;
        float* red = (float*)(lds + 17 * 1024 * 4);
        for (int idx = tid; idx < 17 * 1024; idx += 512) { const int bb = idx >> 10, k = idx & 1023; const float v = bb < 16 ? P->c[bb * 1024 + k] : P->c_ctx[k]; s[idx] = siluf_(v); }
        __syncthreads();
        const int col = lane & 15, ksub = lane >> 4, n = item * 16 + col, k0 = wid * 128 + ksub * 32;
        float acc[17];
#pragma unroll
        for (int bb = 0; bb < 17; ++bb) acc[bb] = 0.f;
#pragma unroll 4
        for (int k = k0; k < k0 + 32; ++k) {
            const float w = P->w_mod[(size_t)k * 3072 + n];
#pragma unroll
            for (int bb = 0; bb < 17; ++bb) acc[bb] += s[bb * 1024 + k] * w;
        }
#pragma unroll
        for (int bb = 0; bb < 17; ++bb) red[((wid * 4 + ksub) * 17 + bb) * 16 + col] = acc[bb];
        __syncthreads();
        float* MODF = (float*)(ws + WS_MODF);
        for (int idx = tid; idx < 17 * 16; idx += 512) {
            const int bb = idx >> 4, l = idx & 15; float sum = 0.f;
#pragma unroll
            for (int w = 0; w < 32; ++w) sum += red[(w * 17 + bb) * 16 + l];
            MODF[bb * 3072 + item * 16 + l] = sum + P->b_mod[item * 16 + l];
        }
        __syncthreads();
    }
    if (bx == (200 % G)) {
        f32x2* rope = (f32x2*)(ws + WS_ROPE);
        for (int idx = tid; idx < 1024; idx += 512) {
            const int pos = idx >> 4, f = idx & 15;
            const float inv = powf(10000.0f, -(float)(2 * f) / 32.0f);
            const float ang = (float)pos * inv;
            rope[idx] = (f32x2){cosf(ang), sinf(ang)};
        }
    }
    LAS float* scr = (LAS float*)((LAS unsigned char*)lds + wid * 16384);
    const int gw = bx * 8 + wid, NGW = G * 8;
    constexpr int I_IN = 16 * 256, I_SQ = 16 * 32;
    for (int it = gw; it < I_IN + 3 * I_SQ; it += NGW) {
        int r = it;
        if (r < I_IN) { transpose_item(P->w_in, 1024, NIN, (bf16_t*)(ws + WS_WIN), scr, r, lane); continue; } r -= I_IN;
        if (r < I_SQ) { transpose_item(P->w_attn_out, 1024, 1024, (bf16_t*)(ws + WS_WA), scr, r, lane); continue; } r -= I_SQ;
        if (r < I_SQ) { transpose_item(P->w_lru_out, 1024, 1024, (bf16_t*)(ws + WS_WL), scr, r, lane); continue; } r -= I_SQ;
        transpose_item(P->w_out, 1024, 1024, (bf16_t*)(ws + WS_WO), scr, r, lane);
    }
}

__device__ __forceinline__ void phase0b(KP P, int wid, int lane) {
    const float* MODF = (const float*)(P->ws + WS_MODF);
    bf16_t* XN = (bf16_t*)(P->ws + WS_XN);
    const int gw = blockIdx.x * 8 + wid, NGW = gridDim.x * 8;
    const int per = (MALL + NGW - 1) / NGW;
    int r0 = gw * per, r1 = r0 + per; if (r1 > MALL) r1 = MALL;
    f32x4 g[4], sc[4], sh[4];
#pragma unroll
    for (int j = 0; j < 4; ++j) g[j] = *(const f32x4*)(P->g_pre + 4 * lane + 256 * j);
    int cur = -1;
    for (int row = r0; row < r1; ++row) {
        const int bb = row < ML ? (row >> 11) : 16;
        if (bb != cur) {
            cur = bb;
#pragma unroll
            for (int j = 0; j < 4; ++j) { sh[j] = *(const f32x4*)(MODF + bb * 3072 + 4 * lane + 256 * j); sc[j] = *(const f32x4*)(MODF + bb * 3072 + 1024 + 4 * lane + 256 * j);
                sc[j] = (sc[j] + 1.0f) * g[j]; }
        }
        const float* xr = row < ML ? P->x + (size_t)row * 1024 : P->ctx + (size_t)(row - ML) * 1024;
        f32x4 v[4]; float s = 0.f;
#pragma unroll
        for (int j = 0; j < 4; ++j) { v[j] = *(const f32x4*)(xr + 4 * lane + 256 * j); s += (v[j][0] * v[j][0] + v[j][1] * v[j][1]) + (v[j][2] * v[j][2] + v[j][3] * v[j][3]); }
        const float rstd = rsqrtf(wave_sum(s) * (1.0f / 1024.0f) + NORM_EPS);
#pragma unroll
        for (int j = 0; j < 4; ++j) {
            const f32x4 o = v[j] * rstd * sc[j] + sh[j];
            u32x2 w; w.x = pk_bf16(o[0], o[1]); w.y = pk_bf16(o[2], o[3]);
            *(u32x2*)(XN + (size_t)row * 1024 + 4 * lane + 256 * j) = w;
        }
    }
}

constexpr int LRU_DIRB = 59392;
constexpr int LRU_XCF = 0;
constexpr int LRU_XCB = 16384;
constexpr int LRU_SA = 16384 + 9216;
constexpr int LRU_SU = LRU_SA + 4 * 1040 * 4;
constexpr int LRU_CARRY = LRU_SU + 4 * 1040 * 4;
constexpr int LRU_CW = 2 * LRU_DIRB;
static_assert(LRU_CARRY + 256 <= LRU_DIRB && LRU_CW + 5 * 64 * 4 <= 131072, "lru lds");

__device__ __forceinline__ void lru_unit(KP P, unsigned char* lds_g, bf16_t* ZLOUT, int b, int nb, int tid, int wid, int lane) {
    unsigned char* ws = P->ws;
    LAS unsigned char* lds = (LAS unsigned char*)lds_g;
    const bf16_t* XR = (const bf16_t*)(ws + WS_XR) + (size_t)b * LALL * 1024 + nb * 64;
    bf16_t* HF = (bf16_t*)(ws + WS_XN) + (size_t)b * SEQ * 1024 + nb * 64;
    const bf16_t* GRZ = (const bf16_t*)(ws + WS_GR) + (size_t)b * SEQ * 1024 + nb * 64;
    bf16_t* ZL = ZLOUT + (size_t)b * SEQ * 1024 + nb * 64;
    const int tok = tid >> 3, cc = tid & 7;
    const unsigned aoff = tok * 1024 + cc * 8;
    if (tid < 320) { const int j = tid >> 6, ch = tid & 63; ((LAS float*)(lds + LRU_CW))[tid] = j < 4 ? P->conv_w[j * 1024 + nb * 64 + ch] : P->conv_b[nb * 64 + ch]; }
    const LAS float* cwl = (const LAS float*)(lds + LRU_CW) + cc * 8;
    const int wdir = wid >> 2, w4 = wid & 3;
    LAS unsigned char* ldsd = lds + wdir * LRU_DIRB;
    const int tt = w4 & 1, nh = w4 >> 1, hh = lane >> 5, jch = nh * 32 + (lane & 31), chB = nb * 64 + jch;
    const int sc_c = 16 * w4 + (lane & 15), sc_seg = lane >> 4;
    bf16x8 wA[4], wX[4];
    {
        const float* wa = P->w_rg_a + (size_t)(wdir * 16 + nb) * 4096 + jch;
        const float* wx = P->w_rg_x + (size_t)(wdir * 16 + nb) * 4096 + jch;
#pragma unroll
        for (int ks = 0; ks < 4; ++ks) {
            unsigned ua[4], ux[4];
#pragma unroll
            for (int j2 = 0; j2 < 4; ++j2) {
                const int i0 = 16 * ks + 8 * hh + 2 * j2;
                ua[j2] = pk_bf16(wa[i0 * 64], wa[(i0 + 1) * 64]);
                ux[j2] = pk_bf16(wx[i0 * 64], wx[(i0 + 1) * 64]);
            }
            wA[ks] = __builtin_bit_cast(bf16x8, (u32x4){ua[0], ua[1], ua[2], ua[3]});
            wX[ks] = __builtin_bit_cast(bf16x8, (u32x4){ux[0], ux[1], ux[2], ux[3]});
        }
    }
    const float ba2 = -1.4426950408889634f * P->b_rg_a[wdir * 1024 + chB], bx2 = -1.4426950408889634f * P->b_rg_x[wdir * 1024 + chB];
    const float sp8 = -8.0f * 1.4426950408889634f * log1pf(__expf(-P->lru_lambda[wdir * 1024 + chB]));
    if (tid < 64) { ((LAS float*)(lds + LRU_CARRY))[tid] = 0.f; ((LAS float*)(lds + LRU_DIRB + LRU_CARRY))[tid] = 0.f; }
    u32x4 xr[2][4];
#define LRU_LOAD_XR(IT) do { const int cf_ = (IT), cb_ = (IT) < 4 ? 3 - (IT) : 39 - (IT); \
        _Pragma("unroll") for (int d = 0; d < 2; ++d) { const int ci = d ? cb_ : cf_, lo = ci < 4 ? 0 : CTXL, hi = ci < 4 ? CTXL : LALL; \
            _Pragma("unroll") for (int j = 0; j < 4; ++j) { const int pp = ci * 64 + tok - 1 + j; xr[d][j] = (u32x4){0u, 0u, 0u, 0u}; \
                if (pp >= lo && pp < hi) xr[d][j] = *(const u32x4*)(XR + (ptrdiff_t)(ci * 64 - 1 + j) * 1024 + aoff); } } } while (0)
    LRU_LOAD_XR(0);
    __syncthreads();
#pragma unroll 1
    for (int it = 0; it < 36; ++it) {
        const int cf = it, cb = it < 4 ? 3 - it : 39 - it;
        {
            float xc[2][8];
            { const f32x4 c0 = *(const LAS f32x4*)(cwl + 256), c1 = *(const LAS f32x4*)(cwl + 260);
#pragma unroll
              for (int d = 0; d < 2; ++d) { xc[d][0] = c0[0]; xc[d][1] = c0[1]; xc[d][2] = c0[2]; xc[d][3] = c0[3]; xc[d][4] = c1[0]; xc[d][5] = c1[1]; xc[d][6] = c1[2]; xc[d][7] = c1[3]; } }
#pragma unroll
            for (int j = 0; j < 4; ++j) {
                const f32x4 w0 = *(const LAS f32x4*)(cwl + j * 64), w1 = *(const LAS f32x4*)(cwl + j * 64 + 4);
#pragma unroll
                for (int d = 0; d < 2; ++d) {
                    const u32x4 v = xr[d][j];
                    xc[d][0] += w0[0] * bf_lo(v.x); xc[d][1] += w0[1] * bf_hi(v.x); xc[d][2] += w0[2] * bf_lo(v.y); xc[d][3] += w0[3] * bf_hi(v.y);
                    xc[d][4] += w1[0] * bf_lo(v.z); xc[d][5] += w1[1] * bf_hi(v.z); xc[d][6] += w1[2] * bf_lo(v.w); xc[d][7] += w1[3] * bf_hi(v.w);
                }
            }
#pragma unroll
            for (int d = 0; d < 2; ++d) {
                LAS float* XCF = (LAS float*)(lds + d * LRU_DIRB + LRU_XCF);
                LAS unsigned char* XCB = lds + d * LRU_DIRB + LRU_XCB;
                *(LAS f32x4*)(XCF + tok * 64 + cc * 8) = (f32x4){xc[d][0], xc[d][1], xc[d][2], xc[d][3]};
                *(LAS f32x4*)(XCF + tok * 64 + cc * 8 + 4) = (f32x4){xc[d][4], xc[d][5], xc[d][6], xc[d][7]};
                u32x4 w; w.x = pk_bf16(xc[d][0], xc[d][1]); w.y = pk_bf16(xc[d][2], xc[d][3]); w.z = pk_bf16(xc[d][4], xc[d][5]); w.w = pk_bf16(xc[d][6], xc[d][7]);
                *(LAS u32x4*)(XCB + tok * 144 + cc * 16) = w;
            }
        }
        if (it + 1 < 36) LRU_LOAD_XR(it + 1);
        u32x4 stg[2], stf[2];
#pragma unroll
        for (int d = 0; d < 2; ++d) {
            const int ci = d ? cb : cf; const bool first = d ? (ci >= 20) : (ci <= 19);
            stg[d] = (u32x4){0u, 0u, 0u, 0u}; stf[d] = stg[d];
            if (ci >= 4 && !first) { const size_t off = (size_t)(ci * 64 - CTXL) * 1024 + aoff; stg[d] = *(const u32x4*)(GRZ + off); stf[d] = *(const u32x4*)(HF + off); }
        }
        LDS_BARRIER();
        {
            const LAS unsigned char* XCB = ldsd + LRU_XCB;
            f32x16 accA = {}, accX = {};
#pragma unroll
            for (int ks = 0; ks < 4; ++ks) {
                const bf16x8 af = *(const LAS bf16x8*)(XCB + (32 * tt + (lane & 31)) * 144 + (16 * ks + 8 * hh) * 2);
                accA = __builtin_amdgcn_mfma_f32_32x32x16_bf16(af, wA[ks], accA, 0, 0, 0);
                accX = __builtin_amdgcn_mfma_f32_32x32x16_bf16(af, wX[ks], accX, 0, 0, 0);
            }
            const int sbase = wdir == 0 ? (2 * tt * 1040 + 4 * hh * 64 + jch) : ((3 - 2 * tt) * 1040 + (15 - 4 * hh) * 64 + jch - 1744);
            const LAS float* xcf = (const LAS float*)(ldsd + LRU_XCF) + (32 * tt + 4 * hh) * 64 + jch;
            LAS float* SA = (LAS float*)(ldsd + LRU_SA) + sbase;
            LAS float* SU = (LAS float*)(ldsd + LRU_SU) + sbase;
            float av[16], uv[16];
#pragma unroll
            for (int r = 0; r < 16; ++r) {
                const float ra = __builtin_amdgcn_rcpf(1.0f + __builtin_amdgcn_exp2f(accA[r] * -1.4426950408889634f + ba2));
                const float ix = __builtin_amdgcn_rcpf(1.0f + __builtin_amdgcn_exp2f(accX[r] * -1.4426950408889634f + bx2));
                av[r] = __builtin_amdgcn_exp2f(sp8 * ra);
                uv[r] = __builtin_amdgcn_sqrtf(1.0f - av[r] * av[r]) * ix * xcf[(8 * (r >> 2) + (r & 3)) * 64];
            }
            if (wdir == 0) {
#pragma unroll
                for (int r = 0; r < 16; ++r) { const int cr = (r >> 3) * 1040 + (8 * ((r >> 2) & 1) + (r & 3)) * 64; SA[cr] = av[r]; SU[cr] = uv[r]; }
            } else {
#pragma unroll
                for (int r = 0; r < 16; ++r) { const int cr = (r >> 3) * 1040 + (8 * ((r >> 2) & 1) + (r & 3)) * 64; SA[1744 - cr] = av[r]; SU[1744 - cr] = uv[r]; }
            }
        }
        LDS_BARRIER();
        {
            LAS float* SA = (LAS float*)(ldsd + LRU_SA) + sc_seg * 1040 + sc_c;
            LAS float* SU = (LAS float*)(ldsd + LRU_SU) + sc_seg * 1040 + sc_c;
            LAS float* CARRY = (LAS float*)(ldsd + LRU_CARRY);
            float A = 1.f, U = 0.f;
#pragma unroll
            for (int s2 = 0; s2 < 16; ++s2) { const float a_ = SA[s2 * 64], u_ = SU[s2 * 64]; U = a_ * U + u_; A *= a_; }
#pragma unroll
            for (int d = 16; d < 64; d <<= 1) {
                const float Ap = __shfl_up(A, d), Up = __shfl_up(U, d);
                if (lane >= d) { U = A * Up + U; A = A * Ap; }
            }
            float Ae = __shfl_up(A, 16), Ue = __shfl_up(U, 16);
            if (sc_seg == 0) { Ae = 1.f; Ue = 0.f; }
            const float hc = CARRY[sc_c];
            float h = Ae * hc + Ue;
            if (sc_seg == 3) CARRY[sc_c] = A * hc + U;
#pragma unroll
            for (int s2 = 0; s2 < 16; ++s2) { h = SA[s2 * 64] * h + SU[s2 * 64]; SU[s2 * 64] = h; }
        }
        LDS_BARRIER();
#pragma unroll
        for (int d = 0; d < 2; ++d) {
            const int ci = d ? cb : cf;
            if (ci >= 4) {
                const int tau = d ? 63 - tok : tok;
                const LAS float* SU = (const LAS float*)(lds + d * LRU_DIRB + LRU_SU) + (tau >> 4) * 1040 + (tau & 15) * 64 + cc * 8;
                const f32x4 h0 = *(const LAS f32x4*)SU, h1 = *(const LAS f32x4*)(SU + 4);
                const size_t off = (size_t)(ci * 64 - CTXL) * 1024 + aoff;
                const bool first = d ? (ci >= 20) : (ci <= 19);
                if (first) {
                    u32x4 w; w.x = pk_bf16(h0[0], h0[1]); w.y = pk_bf16(h0[2], h0[3]); w.z = pk_bf16(h1[0], h1[1]); w.w = pk_bf16(h1[2], h1[3]);
                    *(u32x4*)(HF + off) = w;
                } else {
                    const u32x4 f = stf[d], g = stg[d];
                    u32x4 w;
                    w.x = pk_bf16((bf_lo(f.x) + h0[0]) * bf_lo(g.x), (bf_hi(f.x) + h0[1]) * bf_hi(g.x));
                    w.y = pk_bf16((bf_lo(f.y) + h0[2]) * bf_lo(g.y), (bf_hi(f.y) + h0[3]) * bf_hi(g.y));
                    w.z = pk_bf16((bf_lo(f.z) + h1[0]) * bf_lo(g.z), (bf_hi(f.z) + h1[1]) * bf_hi(g.z));
                    w.w = pk_bf16((bf_lo(f.w) + h1[2]) * bf_lo(g.w), (bf_hi(f.w) + h1[3]) * bf_hi(g.w));
                    *(u32x4*)(ZL + off) = w;
                }
            }
        }
    }
    __syncthreads();
}

constexpr int ATT_KSLOT = 8192, ATT_V0 = 3 * 8192, ATT_VBUF = 16384, ATT_STASH = ATT_V0 + 2 * ATT_VBUF;
__device__ __forceinline__ s16x4 vtr(const LAS unsigned char* p) { return __builtin_bit_cast(s16x4, __builtin_amdgcn_ds_read_tr16_b64_v4i16((LAS s16x4*)p)); }

__device__ __forceinline__ void attn_qk(const LAS unsigned char* lds, int kcur, const int (&kaddr)[4], const bf16x8 (&qf)[4], const f32x16& cinit, f32x16& p0, f32x16& p1) {
    p0 = cinit; p1 = cinit;
#pragma unroll
    for (int ks = 0; ks < 4; ++ks) {
        const bf16x8 k0 = *(const LAS bf16x8*)(lds + kcur + kaddr[ks]);
        const bf16x8 k1 = *(const LAS bf16x8*)(lds + kcur + kaddr[ks] + 4096);
        p0 = __builtin_amdgcn_mfma_f32_32x32x16_bf16(k0, qf[ks], p0, 0, 0, 0);
        p1 = __builtin_amdgcn_mfma_f32_32x32x16_bf16(k1, qf[ks], p1, 0, 0, 0);
    }
}
__device__ __forceinline__ void attn_tile(const LAS unsigned char* lds, int knext, int vcur, const int (&kaddr)[4], const int (&vaddr)[4], const bf16x8 (&qf)[4],
                                          f32x16& p0, f32x16& p1, f32x16& pn0, f32x16& pn1, f32x16 (&o)[4], float& m_ref, float& l, float& mx, f32x16& negm) {
    constexpr float THR = 8.0f;
    if (__builtin_amdgcn_ballot_w64(mx > m_ref + THR) != 0ull) {
        const float mf = fmaxf(mx, __shfl_xor(mx, 32));
        if (mf > m_ref + THR) {
            const float delta = mf - m_ref, alpha = __builtin_amdgcn_exp2f(-delta);
            l *= alpha;
#pragma unroll
            for (int d = 0; d < 4; ++d) o[d] = o[d] * alpha;
            p0 = p0 - delta; p1 = p1 - delta;
            m_ref = mf;
#pragma unroll
            for (int r = 0; r < 16; ++r) negm[r] = -mf;
        }
    }
    attn_qk(lds, knext, kaddr, qf, negm, pn0, pn1);
    unsigned pa[4][4];
    float ls = 0.f;
#pragma unroll
    for (int r = 0; r < 16; r += 2) {
        const float e0 = __builtin_amdgcn_exp2f(p0[r]), e1 = __builtin_amdgcn_exp2f(p0[r + 1]);
        const float f0 = __builtin_amdgcn_exp2f(p1[r]), f1 = __builtin_amdgcn_exp2f(p1[r + 1]);
        ls += (e0 + e1) + (f0 + f1);
        pa[r >> 3][(r & 7) >> 1] = pk_bf16(e0, e1);
        pa[2 + (r >> 3)][(r & 7) >> 1] = pk_bf16(f0, f1);
    }
    l += ls;
    {
        float mn = pn0[0];
#pragma unroll
        for (int r = 1; r < 16; ++r) mn = fmaxf(mn, pn0[r]);
#pragma unroll
        for (int r = 0; r < 16; ++r) mn = fmaxf(mn, pn1[r]);
        mx = mn + m_ref;
    }
    bf16x8 vf[2][4];
#define ATT_LDV(S, BUF) do { _Pragma("unroll") for (int dvt = 0; dvt < 4; ++dvt) { \
        const s16x4 lo = vtr(lds + vcur + vaddr[dvt] + (S) * 4096), hh2 = vtr(lds + vcur + vaddr[dvt] + (S) * 4096 + 2048); \
        vf[BUF][dvt] = (bf16x8){lo[0], lo[1], lo[2], lo[3], hh2[0], hh2[1], hh2[2], hh2[3]}; } } while (0)
    ATT_LDV(0, 0);
#pragma unroll
    for (int s = 0; s < 4; ++s) {
        if (s < 3) ATT_LDV(s + 1, (s + 1) & 1);
        const bf16x8 pb = __builtin_bit_cast(bf16x8, (u32x4){pa[s][0], pa[s][1], pa[s][2], pa[s][3]});
#pragma unroll
        for (int dvt = 0; dvt < 4; ++dvt) o[dvt] = __builtin_amdgcn_mfma_f32_32x32x16_bf16(vf[s & 1][dvt], pb, o[dvt], 0, 0, 0);
    }
#undef ATT_LDV
}

__device__ __forceinline__ void attn_unit(KP P, unsigned char* lds_g, bf16_t* ZOUT, int b, int h, int qb, float lam, int tid, int wid, int lane) {
    unsigned char* ws = P->ws;
    LAS unsigned char* lds = (LAS unsigned char*)lds_g;
    bf16_t* QZ = (bf16_t*)(ws + WS_Q);
    const bf16_t* KA = (const bf16_t*)(ws + WS_KA);
    const bf16_t* VA = (const bf16_t*)(ws + WS_VA);
    const bf16_t* GA = (const bf16_t*)(ws + WS_GA);
    const int q = lane & 31, hi = lane >> 5;
    const size_t qrow_u = ((size_t)b * SEQ + qb * 256 + wid * 32) * 1024 + h * 128;
    const unsigned qoff = q * 1024 + 8 * hi;
    constexpr float C2 = 0.125f * 1.4426950408889634f;
    constexpr float THR = 8.0f;
    unsigned koff; unsigned voff[2];
    { const int row = 8 * wid + (lane >> 3), pc = lane & 7; koff = row * 1024 + (pc ^ ((row >> 1) & 7)) * 8; }
#pragma unroll
    for (int i = 0; i < 2; ++i) { const int row = 4 * (2 * wid + i) + (lane >> 4), pc = lane & 15, c = (((pc >> 2) ^ (row & 3)) << 2) | (pc & 3); voff[i] = row * 1024 + c * 8; }
    const int kpiece = wid * 1024, vpiece = ATT_V0 + wid * 2048;
#define ATT_DMA(G, L) do { unsigned keep_; const void* g_ = (const void*)(G); const unsigned l_ = (unsigned)__builtin_amdgcn_readfirstlane((int)(unsigned)(uintptr_t)(L)); \
        asm volatile("s_mov_b32 %0, m0\n\ts_mov_b32 m0, %2\n\ts_nop 0\n\tglobal_load_lds_dwordx4 %1, off\n\ts_mov_b32 m0, %0" : "=&s"(keep_) : "v"(g_), "s"(l_) : "memory"); } while (0)
    int kaddr[4];
#pragma unroll
    for (int ks = 0; ks < 4; ++ks) kaddr[ks] = q * 128 + 16 * ((2 * ks + hi) ^ ((q >> 1) & 7));
    int vaddr[4];
    { const int g = lane >> 4, qq = (lane >> 2) & 3, pp = lane & 3, h2 = g >> 1;
#pragma unroll
      for (int dvt = 0; dvt < 4; ++dvt) vaddr[dvt] = ATT_V0 + (4 * h2 + qq) * 256 + ((dvt ^ qq) * 64) + (g & 1) * 32 + pp * 8; }

    LAS unsigned* o1s = (LAS unsigned*)(lds + ATT_STASH + wid * 8192) + lane;
    const bf16_t* Kb = KA + (size_t)b * LALL * 1024 + h * 128;
    const bf16_t* Vb = VA + (size_t)b * LALL * 1024 + h * 128;

#pragma unroll 1
    for (int pass = 0; pass < 2; ++pass) {
        bf16x8 qf[4];
#pragma unroll
        for (int ks = 0; ks < 4; ++ks) qf[ks] = *(const bf16x8*)(QZ + qrow_u + pass * 64 + 16 * ks + qoff);
        const bf16_t* Kp = Kb + pass * 64;
        f32x16 o[4];
#pragma unroll
        for (int d = 0; d < 4; ++d) o[d] = (f32x16){};
        float m_ref = -1e30f, l = 0.f;
        {
            ATT_DMA(Kp + koff, lds + kpiece); ATT_DMA(Kp + 65536 + koff, lds + ATT_KSLOT + kpiece);
            ATT_DMA(Vb + voff[0], lds + vpiece); ATT_DMA(Vb + voff[1], lds + vpiece + 1024);
            asm volatile("s_waitcnt vmcnt(0)" ::: "memory");
        }
        __syncthreads();
        asm volatile("" :: "v"(qf[0]), "v"(qf[1]), "v"(qf[2]), "v"(qf[3]));
        f32x16 pa0, pa1, pb0, pb1, negm = {};
        attn_qk(lds, 0, kaddr, qf, negm, pa0, pa1);
        float mxc = pa0[0];
#pragma unroll
        for (int r = 1; r < 16; ++r) mxc = fmaxf(mxc, pa0[r]);
#pragma unroll
        for (int r = 0; r < 16; ++r) mxc = fmaxf(mxc, pa1[r]);
        m_ref = fmaxf(mxc, __shfl_xor(mxc, 32));
        pa0 = pa0 - m_ref; pa1 = pa1 - m_ref;
#pragma unroll
        for (int r = 0; r < 16; ++r) negm[r] = -m_ref;
        int ks1 = ATT_KSLOT, ks2 = 2 * ATT_KSLOT;
#define ATT_STEP(T, PC0, PC1, PN0, PN1, VCUR, VNXT) do { \
            const size_t rk = (size_t)((T) + 2 < LALL / 64 ? (T) + 2 : LALL / 64 - 1) * 65536, rv = (size_t)((T) + 1 < LALL / 64 ? (T) + 1 : LALL / 64 - 1) * 65536; \
            ATT_DMA(Kp + rk + koff, lds + ks2 + kpiece); ATT_DMA(Vb + rv + voff[0], lds + (VNXT) + vpiece); ATT_DMA(Vb + rv + voff[1], lds + (VNXT) + vpiece + 1024); \
            attn_tile(lds, ks1, (VCUR), kaddr, vaddr, qf, PC0, PC1, PN0, PN1, o, m_ref, l, mxc, negm); \
            asm volatile("s_waitcnt vmcnt(0)" ::: "memory"); \
            { const int k3 = ks1 + ks2 == 3 * ATT_KSLOT ? 0 : (ks1 + ks2 == ATT_KSLOT ? 2 * ATT_KSLOT : ATT_KSLOT); ks1 = ks2; ks2 = k3; } \
            __syncthreads(); } while (0)
#pragma unroll 1
        for (int t = 0; t < LALL / 64; t += 2) {
            ATT_STEP(t, pa0, pa1, pb0, pb1, 0, ATT_VBUF);
            ATT_STEP(t + 1, pb0, pb1, pa0, pa1, ATT_VBUF, 0);
        }
#undef ATT_STEP
        const float lt = l + __shfl_xor(l, 32);
        const float inv = 1.0f / lt;
        if (pass == 0) {
#pragma unroll
            for (int d = 0; d < 4; ++d)
#pragma unroll
                for (int r = 0; r < 16; r += 2) o1s[(d * 8 + (r >> 1)) * 64] = pk_bf16(o[d][r] * inv, o[d][r + 1] * inv);
        } else {
            const float li = lam * inv;
            float ss = 0.f;
#pragma unroll
            for (int d = 0; d < 4; ++d) {
#pragma unroll
                for (int r = 0; r < 16; r += 2) {
                    const unsigned o1 = o1s[(d * 8 + (r >> 1)) * 64];
                    const float a0 = bf_lo(o1) - li * o[d][r], a1 = bf_hi(o1) - li * o[d][r + 1];
                    ss += a0 * a0 + a1 * a1;
                }
                asm volatile("" ::: "memory");
            }
            ss += __shfl_xor(ss, 32);
            const float rstd = rsqrtf(ss * (1.0f / 128.0f) + NORM_EPS) * (1.0f - LAM_INIT);
            const unsigned eoff = q * 1024 + 8 * hi;
#pragma unroll
            for (int d = 0; d < 4; ++d)
#pragma unroll
                for (int pr = 0; pr < 2; ++pr) {
                    float va[4], vb[4];
#pragma unroll
                    for (int i = 0; i < 4; i += 2) {
                        const unsigned oa = o1s[(d * 8 + 4 * pr + (i >> 1)) * 64], ob = o1s[(d * 8 + 4 * pr + 2 + (i >> 1)) * 64];
                        va[i] = bf_lo(oa) - li * o[d][8 * pr + i]; va[i + 1] = bf_hi(oa) - li * o[d][8 * pr + i + 1];
                        vb[i] = bf_lo(ob) - li * o[d][8 * pr + 4 + i]; vb[i + 1] = bf_hi(ob) - li * o[d][8 * pr + 4 + i + 1];
                    }
#pragma unroll
                    for (int i = 0; i < 4; ++i) {
                        auto rr = __builtin_amdgcn_permlane32_swap(__float_as_uint(va[i]), __float_as_uint(vb[i]), false, false);
                        va[i] = __uint_as_float(rr[0]); vb[i] = __uint_as_float(rr[1]);
                    }
                    const int dv0 = 32 * d + 16 * pr + 8 * hi;
                    const f32x4 gs0 = *(const f32x4*)(P->g_subln + dv0), gs1 = *(const f32x4*)(P->g_subln + dv0 + 4);
                    const u32x4 ga = *(const u32x4*)(GA + qrow_u + 32 * d + 16 * pr + eoff);
                    u32x4 w;
                    w.x = pk_bf16(va[0] * rstd * gs0[0] * bf_lo(ga.x), va[1] * rstd * gs0[1] * bf_hi(ga.x));
                    w.y = pk_bf16(va[2] * rstd * gs0[2] * bf_lo(ga.y), va[3] * rstd * gs0[3] * bf_hi(ga.y));
                    w.z = pk_bf16(vb[0] * rstd * gs1[0] * bf_lo(ga.z), vb[1] * rstd * gs1[1] * bf_hi(ga.z));
                    w.w = pk_bf16(vb[2] * rstd * gs1[2] * bf_lo(ga.w), vb[3] * rstd * gs1[3] * bf_hi(ga.w));
                    *(u32x4*)(ZOUT + qrow_u + 32 * d + 16 * pr + eoff) = w;
                    asm volatile("" ::: "memory");
                }
        }
    }
}

__device__ __forceinline__ void phase4(KP P, int wid, int lane) {
    const float* MODF = (const float*)(P->ws + WS_MODF);
    const bf16_t* Y = (const bf16_t*)(P->ws + WS_T);
    const float* PART = (const float*)(P->ws + WS_PART);
    const int gw = blockIdx.x * 8 + wid, NGW = gridDim.x * 8;
    f32x4 gp[4];
#pragma unroll
    for (int j = 0; j < 4; ++j) gp[j] = *(const f32x4*)(P->g_post + 4 * lane + 256 * j);
    for (int row = gw; row < ML; row += NGW) {
        const int b = row >> 11;
        float ss = PART[(size_t)row * 16 + (lane & 15)];
        ss += __shfl_xor(ss, 1); ss += __shfl_xor(ss, 2); ss += __shfl_xor(ss, 4); ss += __shfl_xor(ss, 8);
        const float rstd = rsqrtf(ss * (1.0f / 1024.0f) + NORM_EPS);
#pragma unroll
        for (int j = 0; j < 4; ++j) {
            const int c = 4 * lane + 256 * j;
            const f32x4 xv = *(const f32x4*)(P->x + (size_t)row * 1024 + c);
            const u32x2 yb = *(const u32x2*)(Y + (size_t)row * 1024 + c);
            const f32x4 yv = (f32x4){bf_lo(yb.x), bf_hi(yb.x), bf_lo(yb.y), bf_hi(yb.y)};
            const f32x4 gt = *(const f32x4*)(MODF + b * 3072 + 2048 + c);
            *(f32x4*)(P->out + (size_t)row * 1024 + c) = xv + gt * (yv * rstd * gp[j]);
        }
    }
}

#define XB_TMO      128
#define XB_XCNT(j)  (256  + 64 * (j))
#define XB_XSUB(j)  (1280 + 64 * (j))
#define XB_XGEN(j)  (2304 + 64 * (j))
#define XB_TOP      3328
#define XB_TOPGEN   3392
#define XCD_BAR_WORDS 3456
#define XB_SPIN_CAP (1u << 18)

__device__ __forceinline__ unsigned xb_ld(unsigned* p)              { return __hip_atomic_load(p, __ATOMIC_RELAXED, __HIP_MEMORY_SCOPE_AGENT); }
__device__ __forceinline__ unsigned xb_add(unsigned* p, unsigned v) { return __hip_atomic_fetch_add(p, v, __ATOMIC_RELAXED, __HIP_MEMORY_SCOPE_AGENT); }
__device__ __forceinline__ unsigned xb_xcc_id() { return (unsigned)__builtin_amdgcn_s_getreg((3 << 11) | 20) & 0xFu; }
#define XB_SPIN(cond, bar) do { unsigned _sp = 0; while (cond) { __builtin_amdgcn_s_sleep(1); \
    if ((++_sp & 255u) == 0u) { if (xb_ld(&(bar)[XB_TMO])) break; if (_sp > XB_SPIN_CAP) { atomicAdd(&(bar)[XB_TMO], 1u); break; } } } } while (0)

struct XcdBarrier {
    unsigned* bar; unsigned x;
    volatile LAS unsigned* st;
};

__device__ __forceinline__ XcdBarrier xcd_barrier_post(unsigned* bar, volatile LAS unsigned* st) {
    XcdBarrier b; b.bar = bar; b.x = xb_xcc_id(); b.st = st;
    if (threadIdx.x == 0) (void)xb_add(&bar[XB_XCNT(b.x)], 1u);
    return b;
}
__device__ __forceinline__ void xcd_barrier_complete(unsigned* bar, unsigned x, unsigned& nloc, unsigned& nx) {
    const unsigned G = gridDim.x * gridDim.y * gridDim.z;
    unsigned sum, cnt, mine, sp = 0u;
    for (;;) {
        sum = 0u; cnt = 0u; mine = 0u;
#pragma unroll
        for (unsigned j = 0; j < 16; ++j) { const unsigned c = xb_ld(&bar[XB_XCNT(j)]); sum += c; cnt += (c > 0u) ? 1u : 0u; mine = (j == x) ? c : mine; }
        if (sum == G) break;
        __builtin_amdgcn_s_sleep(1);
        if ((++sp & 255u) == 0u) { if (xb_ld(&bar[XB_TMO])) break; if (sp > XB_SPIN_CAP) { atomicAdd(&bar[XB_TMO], 1u); break; } }
    }
    nloc = mine > 0u ? mine : 1u; nx = cnt > 0u ? cnt : 1u;
}

__device__ __forceinline__ void xcd_barrier(const XcdBarrier& b) {
    asm volatile("s_waitcnt vmcnt(0)" ::: "memory");
    __syncthreads();
    if (threadIdx.x == 0) {
        unsigned* bar = b.bar;
        __builtin_amdgcn_s_waitcnt(0);
        unsigned nloc = b.st[0], nx = b.st[1];
        if (nloc == 0u) { xcd_barrier_complete(bar, b.x, nloc, nx); b.st[0] = nloc; b.st[1] = nx; }
        const unsigned old = xb_add(&bar[XB_XSUB(b.x)], 1u);
        const unsigned gen = old / nloc;
        if (old + 1u == (gen + 1u) * nloc) {
            __builtin_amdgcn_fence(__ATOMIC_RELEASE, "agent");
            asm volatile("s_waitcnt vmcnt(0)" ::: "memory");
            const unsigned og = xb_add(&bar[XB_TOP], 1u);
            const unsigned tg = og / nx;
            if (og + 1u == (tg + 1u) * nx) xb_add(&bar[XB_TOPGEN], 1u);
            else XB_SPIN(xb_ld(&bar[XB_TOPGEN]) == tg, bar);
            __builtin_amdgcn_fence(__ATOMIC_ACQUIRE, "agent");
            xb_add(&bar[XB_XGEN(b.x)], 1u);
            asm volatile("s_waitcnt vmcnt(0)" ::: "memory");
        } else {
            XB_SPIN(xb_ld(&bar[XB_XGEN(b.x)]) == gen, bar);
            __builtin_amdgcn_fence(__ATOMIC_ACQUIRE, "agent");
            asm volatile("s_waitcnt vmcnt(0)" ::: "memory");
        }
    }
    __syncthreads();
}

__global__ void __launch_bounds__(512, 2) hybrid_fwd(Params Pval) {
    KP P = (KP)__builtin_amdgcn_kernarg_segment_ptr();
    extern __shared__ __attribute__((aligned(16))) unsigned char lds[];
    cg::grid_group grid = cg::this_grid();
#define FRESH_TID() int tid = threadIdx.x; asm volatile("" : "+v"(tid)); const int lane = tid & 63, wid = __builtin_amdgcn_readfirstlane(tid >> 6)
    const int G = gridDim.x, bx = blockIdx.x;
    unsigned char* ws = P->ws;
    if (threadIdx.x < 2) ((volatile LAS unsigned*)((LAS unsigned char*)lds + LDS_BARW))[threadIdx.x] = 0u;
    if (bx == 0) for (int i = threadIdx.x; i < (int)(WS_BAR_BYTES / 4); i += 512) __hip_atomic_store((unsigned*)(ws + WS_BAR) + i, 0u, __ATOMIC_RELAXED, __HIP_MEMORY_SCOPE_AGENT);
    __syncthreads();
    LAS unsigned char* ldsl = (LAS unsigned char*)lds;

#ifndef NO_P0A
    { FRESH_TID(); phase0a(P, lds, tid, wid, lane); }
#endif
    grid.sync();
    const XcdBarrier xbar = xcd_barrier_post((unsigned*)(ws + WS_BAR), (volatile LAS unsigned*)((LAS unsigned char*)lds + LDS_BARW));
#ifndef NO_P0B
    { FRESH_TID(); (void)tid; phase0b(P, wid, lane); }
#endif
    xcd_barrier(xbar);
#ifndef NO_P1
    {
        pg8::Gemm g{(const bf16_t*)(ws + WS_XN), (const bf16_t*)(ws + WS_WIN), MALL, NIN, 1024};
        InProjOrder S; S.init(G, bx);
        EpiInProj E{(bf16_t*)(ws + WS_Q), (bf16_t*)(ws + WS_KA), (bf16_t*)(ws + WS_VA), (bf16_t*)(ws + WS_GA), (bf16_t*)(ws + WS_XR), (bf16_t*)(ws + WS_GR), (bf16_t*)P->out,
                    (const f32x2*)(ws + WS_ROPE)};
        pg8::gemm_phase<EpiInProj, InProjOrder, true, true>(ldsl, g, S, E);
    }
#endif
    xcd_barrier(xbar);
    {
        const int vcu = (G % 8 == 0) ? (bx % 8) * (G / 8) + bx / 8 : bx;
#ifndef NO_LRU
        { FRESH_TID(); for (int u = vcu; u < 256; u += G) lru_unit(P, lds, (bf16_t*)(ws + WS_GR), u >> 4, u & 15, tid, wid, lane); }
#endif
#ifndef NO_ATT
        { FRESH_TID();
          float s1 = P->lq1[lane] * P->lk1[lane], s2 = P->lq2[lane] * P->lk2[lane];
          s1 = wave_sum(s1); s2 = wave_sum(s2);
          const float lam = __expf(s1) - __expf(s2) + LAM_INIT;
          for (int u = vcu; u < 1024; u += G) { const int bh = u >> 3; attn_unit(P, lds, (bf16_t*)(ws + WS_Q), bh >> 3, bh & 7, u & 7, lam, tid, wid, lane); } }
#endif
    }
    xcd_barrier(xbar);
#ifndef NO_P3A
    {
        PairOrder S; S.init(G, bx);
        pg8::Gemm g{(const bf16_t*)(ws + WS_Q), (const bf16_t*)(ws + WS_WA), 2 * ML, 2048, 1024};
        static_assert(WS_GR - WS_Q == (size_t)ML * 1024 * 2 && WS_WL - WS_WA == (size_t)1024 * 1024 * 2, "the second merge GEMM's operands must sit one full matrix behind the first's");
        EpiMerge E{(const bf16_t*)P->out, (bf16_t*)(ws + WS_XN)};
        pg8::gemm_phase<EpiMerge, PairOrder, true, true>(ldsl, g, S, E);
    }
#endif
    xcd_barrier(xbar);
#ifndef NO_P3B
    {
        pg8::StaticOrder S; S.init(ML, 1024, G, bx);
        pg8::Gemm g{(const bf16_t*)(ws + WS_XN), (const bf16_t*)(ws + WS_WO), ML, 1024, 1024};
        EpiOut E{(bf16_t*)(ws + WS_T), (float*)(ws + WS_PART)};
        pg8::gemm_phase<EpiOut, pg8::StaticOrder, true, true>(ldsl, g, S, E);
    }
#endif
    xcd_barrier(xbar);
#ifndef NO_P4
    { FRESH_TID(); (void)tid; phase4(P, wid, lane); }
#endif
}

extern "C" void kernel_launch(void* const* d_in, const int* in_sizes, int n_in, void* d_out, int out_size, void* d_ws, size_t ws_size, hipStream_t stream) {
    static int grid_blocks = 0;
    if (grid_blocks == 0) {
        if (n_in != 24 || out_size != ML * DM || ws_size < WS_END) { fprintf(stderr, "kernel_launch: unexpected problem (n_in %d out %d ws %zu)\n", n_in, out_size, ws_size); grid_blocks = -1; return; }
        int dev = 0, cus = 0, per_cu = 0;
        hipGetDevice(&dev);
        hipDeviceGetAttribute(&cus, hipDeviceAttributeMultiprocessorCount, dev);
        if (hipFuncSetAttribute((const void*)hybrid_fwd, hipFuncAttributeMaxDynamicSharedMemorySize, LDS_BYTES) != hipSuccess) { fprintf(stderr, "kernel_launch: hipFuncSetAttribute failed\n"); grid_blocks = -1; return; }
        if (hipOccupancyMaxActiveBlocksPerMultiprocessor(&per_cu, (const void*)hybrid_fwd, 512, LDS_BYTES) != hipSuccess || per_cu < 1) { fprintf(stderr, "kernel_launch: occupancy query failed (%d)\n", per_cu); (void)hipGetLastError(); per_cu = 1; }
        grid_blocks = cus;
        fprintf(stderr, "kernel_launch: cus %d per_cu %d grid %d\n", cus, per_cu, grid_blocks);
    }
    if (grid_blocks < 0) return;
    Params p{};
    const float** pf = (const float**)&p;
    for (int i = 0; i < 24; ++i) pf[i] = (const float*)d_in[i];
    p.out = (float*)d_out; p.ws = (unsigned char*)d_ws;
    void* args[] = {&p};
    hipError_t e = hipLaunchCooperativeKernel((const void*)hybrid_fwd, dim3(grid_blocks), dim3(512), args, LDS_BYTES, stream);
    if (e != hipSuccess) fprintf(stderr, "kernel_launch: cooperative launch failed: %s (grid %d)\n", hipGetErrorString(e), grid_blocks);
}
```

```cpp
#include <hip/hip_runtime.h>
#include <hip/hip_cooperative_groups.h>
#include <cstdio>
#include <cstdint>
namespace cg = cooperative_groups;
namespace pg8 {
#define PG8_LAS __attribute__((address_space(3)))
typedef unsigned short bf16_t;
typedef short bf16x8 __attribute__((ext_vector_type(8)));
typedef float f32x4 __attribute__((ext_vector_type(4)));
typedef unsigned u32x4 __attribute__((ext_vector_type(4)));
constexpr int BM = 256, BK = 64, HALF = 128, HTB = HALF * BK * 2  , STAGE_BYTES = 8 * HTB, NXCD = 8, WGM = 8;

__host__ __device__ __forceinline__ int lds_byte(int r, int c) { const int st = (r >> 4) * 2 + (c >> 5), rr = r & 15, cc = c & 31, ob = rr * 64 + cc * 2; return st * 1024 + (ob ^ (((ob >> 9) & 1) << 5)); }
__host__ __device__ __forceinline__ void stage_rc(int b, int& R, int& C) { const int st = b / 1024, sb = b % 1024, swz = sb ^ (((sb >> 9) & 1) << 5); R = (st >> 1) * 16 + swz / 64; C = (st & 1) * 32 + (swz % 64) / 2; }
__host__ __device__ __forceinline__ int perm32(int rho) { const int n = rho >> 4, i = rho & 15; return 8 * (i >> 2) + 4 * n + (i & 3); }

struct Unit { int pm, pn; };
struct Gemm { const bf16_t* A; const bf16_t* Bt; int M, N, K; };

struct StaticOrder {
    int nM, nN, nwg, G, c;
    __host__ __device__ void init(int M, int N, int G_, int c_) { nM = M / BM; nN = N / BM; nwg = nM * nN; G = G_; c = c_; }
    __host__ __device__ bool next(int i, Unit& u) const {
        const long L = (long)i * G + c; if (L >= nwg) return false;
        int wgid = (int)L; { const int q = nwg / NXCD, r = nwg % NXCD, xcd = wgid % NXCD, off = wgid / NXCD; wgid = (xcd < r ? xcd * (q + 1) : r * (q + 1) + (xcd - r) * q) + off; }
        const int nig = WGM * nN, gid = wgid / nig, fm = gid * WGM, gsz = (nM - fm) < WGM ? (nM - fm) : WGM;
        u.pm = fm + ((wgid % nig) % gsz); u.pn = (wgid % nig) / gsz; return true;
    }
    __device__ __forceinline__ void a_ready(const Unit&) const {}
    __device__ __forceinline__ void done(const Unit&) const {}
};

__device__ __forceinline__ unsigned cvt_pk_bf16(float lo, float hi) { unsigned r; asm volatile("v_cvt_pk_bf16_f32 %0, %1, %2" : "=v"(r) : "v"(lo), "v"(hi)); return r; }
typedef float f32x2 __attribute__((ext_vector_type(2)));
template <class Epi, class Sched, bool ALIGN_EPI = false, bool SP2 = false>
__device__ __forceinline__ void gemm_phase(PG8_LAS unsigned char* lds, const Gemm g, const Sched& S, const Epi& E) {
    int tid_ = threadIdx.x; asm volatile("" : "+v"(tid_));
    const int tid = tid_, wid = __builtin_amdgcn_readfirstlane(tid >> 6), lane = tid & 63, wr = wid >> 2, wc = wid & 3, fr = lane & 15, fq = lane >> 4;
    const int K = g.K, nt = K / BK;
    unsigned voffA[2], voffB[2];
#pragma unroll
    for (int i = 0; i < 2; ++i) { int R, C; stage_rc(tid * 16 + i * 8192, R, C); const int Rb = Epi::PERM ? ((R & ~31) + perm32(R & 31)) : R;
        voffA[i] = (unsigned)(R * K + C) * 2u; voffB[i] = (unsigned)(Rb * K + C) * 2u; }
    const size_t kstep = (size_t)(BK * 2);
    const size_t hstep = (size_t)HALF * K * 2;
    const size_t tstep = 2 * hstep;
    const unsigned ldsw = (unsigned)wid * 1024u;
    const int aoff = lds_byte(wr * 64 + fr, fq * 8), boff = lds_byte(wc * 32 + fr, fq * 8);
#define PG8_SA(b, h) (((b) * 2 + (h)) * HTB)
#define PG8_SB(b, h) ((4 + (b) * 2 + (h)) * HTB)
#define PG8_STAGE(bufoff, gbase, voff) do { _Pragma("unroll") for (int _i = 0; _i < 2; ++_i) \
        __builtin_amdgcn_global_load_lds((const unsigned*)((const char*)(gbase) + (voff)[_i]), (PG8_LAS unsigned*)(lds + (bufoff) + ldsw + _i * 8192), 16, 0, 0); } while (0)
#define PG8_LDA(dst, b, h) do { _Pragma("unroll") for (int m = 0; m < 4; ++m) _Pragma("unroll") for (int k = 0; k < 2; ++k) dst[m][k] = *(const PG8_LAS bf16x8*)(lds + PG8_SA(b, h) + aoff + m * 2048 + k * 1024); } while (0)
#define PG8_LDB(dst, b, h) do { _Pragma("unroll") for (int n = 0; n < 2; ++n) _Pragma("unroll") for (int k = 0; k < 2; ++k) dst[n][k] = *(const PG8_LAS bf16x8*)(lds + PG8_SB(b, h) + boff + n * 2048 + k * 1024); } while (0)
#define PG8_MMA(ai, bj, At, Bt) do { __builtin_amdgcn_s_setprio(1); _Pragma("unroll") for (int m = 0; m < 4; ++m) _Pragma("unroll") for (int n = 0; n < 2; ++n) _Pragma("unroll") for (int k = 0; k < 2; ++k) \
        acc[ai][bj][m][n] = __builtin_amdgcn_mfma_f32_16x16x32_bf16(Bt[n][k], At[m][k], acc[ai][bj][m][n], 0, 0, 0); __builtin_amdgcn_s_setprio(0); } while (0)
#define PG8_WAIT_V(n) asm volatile("s_waitcnt vmcnt(" #n ")" ::: "memory")
#define PG8_WAIT_L(n) asm volatile("s_waitcnt lgkmcnt(" #n ")" ::: "memory")
#define PG8_BAR __builtin_amdgcn_s_barrier()
#define PG8_SCHED __builtin_amdgcn_sched_barrier(0)
    Unit cur, nxt; int ui = 0;
    if (!S.next(0, cur)) return;
    f32x4 acc[2][2][4][2];
#pragma unroll
    for (int a = 0; a < 2; ++a)
#pragma unroll
        for (int b = 0; b < 2; ++b)
#pragma unroll
            for (int m = 0; m < 4; ++m)
#pragma unroll
                for (int n = 0; n < 2; ++n) acc[a][b][m][n] = (f32x4){0.f, 0.f, 0.f, 0.f};
    bf16x8 At[4][2], B0[2][2], B1[2][2];
    const char* cA = (const char*)g.A + (size_t)cur.pm * tstep; const char* cB = (const char*)g.Bt + (size_t)cur.pn * tstep;
    S.a_ready(cur);
    if constexpr (SP2) {
        PG8_STAGE(PG8_SB(0, 0), cB, voffB); PG8_STAGE(PG8_SB(0, 1), cB + hstep, voffB); PG8_STAGE(PG8_SA(0, 0), cA, voffA); PG8_STAGE(PG8_SA(0, 1), cA + hstep, voffA);
        if (wr == 1) PG8_BAR;
        PG8_WAIT_V(2); PG8_BAR;
        PG8_STAGE(PG8_SB(1, 0), cB + kstep, voffB); PG8_STAGE(PG8_SA(1, 0), cA + kstep, voffA); PG8_STAGE(PG8_SB(1, 1), cB + hstep + kstep, voffB);
        PG8_WAIT_V(6); PG8_BAR;
    } else {
        PG8_STAGE(PG8_SB(0, 0), cB, voffB); PG8_STAGE(PG8_SA(0, 0), cA, voffA); PG8_STAGE(PG8_SB(0, 1), cB + hstep, voffB); PG8_STAGE(PG8_SA(0, 1), cA + hstep, voffA);
        if (wr == 1) PG8_BAR;
        PG8_WAIT_V(4); PG8_BAR;
        PG8_STAGE(PG8_SB(1, 0), cB + kstep, voffB); PG8_STAGE(PG8_SA(1, 0), cA + kstep, voffA); PG8_STAGE(PG8_SB(1, 1), cB + hstep + kstep, voffB);
        PG8_WAIT_V(6); PG8_BAR;
    }
    for (;;) {
        const bool has_next = S.next(ui + 1, nxt);
        const char* nA = has_next ? (const char*)g.A + (size_t)nxt.pm * tstep : cA; const char* nB = has_next ? (const char*)g.Bt + (size_t)nxt.pn * tstep : cB;
        for (int t = 0; t < nt; t += 2) {
            const bool last = (t == nt - 2);
            const char* a1 = cA + (size_t)(t + 1) * kstep;
            const char* a2 = last ? nA : cA + (size_t)(t + 2) * kstep; const char* b2 = last ? nB : cB + (size_t)(t + 2) * kstep;
            const char* a3 = a2 + kstep; const char* b3 = b2 + kstep;
            if (last && has_next) S.a_ready(nxt);
            if constexpr (SP2) {
            PG8_LDB(B0, 0, 0); PG8_LDB(B1, 0, 1); PG8_SCHED; PG8_LDA(At, 0, 0); PG8_STAGE(PG8_SA(1, 1), a1 + hstep, voffA);
            PG8_WAIT_V(8); PG8_WAIT_L(0); PG8_BAR; PG8_MMA(0, 0, At, B0); PG8_MMA(0, 1, At, B1); PG8_BAR; PG8_SCHED;
            PG8_LDA(At, 0, 1); PG8_STAGE(PG8_SB(0, 0), b2, voffB); PG8_STAGE(PG8_SB(0, 1), b2 + hstep, voffB); PG8_STAGE(PG8_SA(0, 0), a2, voffA);
            PG8_WAIT_V(8); PG8_WAIT_L(0); PG8_BAR; PG8_MMA(1, 0, At, B0); PG8_MMA(1, 1, At, B1); PG8_BAR; PG8_SCHED;
            PG8_LDB(B0, 1, 0); PG8_LDB(B1, 1, 1); PG8_SCHED; PG8_LDA(At, 1, 0); PG8_STAGE(PG8_SA(0, 1), a2 + hstep, voffA);
            PG8_WAIT_V(8); PG8_WAIT_L(0); PG8_BAR; PG8_MMA(0, 0, At, B0); PG8_MMA(0, 1, At, B1); PG8_BAR; PG8_SCHED;
            PG8_LDA(At, 1, 1); PG8_STAGE(PG8_SB(1, 0), b3, voffB); PG8_STAGE(PG8_SB(1, 1), b3 + hstep, voffB); PG8_STAGE(PG8_SA(1, 0), a3, voffA);
            PG8_WAIT_V(8); PG8_WAIT_L(0); PG8_BAR; PG8_MMA(1, 0, At, B0); PG8_MMA(1, 1, At, B1); PG8_BAR; PG8_SCHED;
            } else {
            PG8_LDB(B0, 0, 0); PG8_SCHED; PG8_LDA(At, 0, 0); PG8_STAGE(PG8_SA(1, 1), a1 + hstep, voffA);
            PG8_WAIT_L(8); PG8_BAR; PG8_WAIT_L(0); PG8_MMA(0, 0, At, B0); PG8_BAR; PG8_SCHED;
            PG8_LDB(B1, 0, 1); PG8_STAGE(PG8_SB(0, 0), b2, voffB);
            PG8_BAR; PG8_WAIT_L(0); PG8_MMA(0, 1, At, B1); PG8_BAR;
            PG8_LDA(At, 0, 1); PG8_STAGE(PG8_SA(0, 0), a2, voffA);
            PG8_BAR; PG8_WAIT_L(0); PG8_MMA(1, 0, At, B0); PG8_BAR; PG8_SCHED;
            PG8_STAGE(PG8_SB(0, 1), b2 + hstep, voffB);
            PG8_WAIT_V(6); PG8_BAR; PG8_MMA(1, 1, At, B1); PG8_BAR;
            PG8_LDB(B0, 1, 0); PG8_SCHED; PG8_LDA(At, 1, 0); PG8_STAGE(PG8_SA(0, 1), a2 + hstep, voffA);
            PG8_WAIT_L(8); PG8_BAR; PG8_WAIT_L(0); PG8_MMA(0, 0, At, B0); PG8_BAR; PG8_SCHED;
            PG8_LDB(B1, 1, 1); PG8_STAGE(PG8_SB(1, 0), b3, voffB);
            PG8_BAR; PG8_WAIT_L(0); PG8_MMA(0, 1, At, B1); PG8_BAR;
            PG8_LDA(At, 1, 1); PG8_STAGE(PG8_SA(1, 0), a3, voffA);
            PG8_BAR; PG8_WAIT_L(0); PG8_MMA(1, 0, At, B0); PG8_BAR; PG8_SCHED;
            PG8_STAGE(PG8_SB(1, 1), b3 + hstep, voffB);
            PG8_WAIT_V(6); PG8_BAR; PG8_MMA(1, 1, At, B1); PG8_BAR;
            }
        }
        if constexpr (ALIGN_EPI) { if (wr == 0) PG8_BAR; }
        if constexpr (!Epi::AFTER_DRAIN) { E(acc, cur, wr, wc, fr, fq); S.done(cur); }
        if (!has_next) break;
        if (!E.chain(cur)) {
#pragma unroll
        for (int a = 0; a < 2; ++a)
#pragma unroll
            for (int b = 0; b < 2; ++b)
#pragma unroll
                for (int m = 0; m < 4; ++m)
#pragma unroll
                    for (int n = 0; n < 2; ++n) acc[a][b][m][n] = (f32x4){0.f, 0.f, 0.f, 0.f};
        }
        cur = nxt; cA = nA; cB = nB; ++ui;
        if constexpr (ALIGN_EPI) { if (wr == 1) PG8_BAR; }
    }
    PG8_WAIT_V(0);
    if constexpr (!ALIGN_EPI) { if (wr == 0) PG8_BAR; }
    PG8_BAR;
    if constexpr (Epi::AFTER_DRAIN) { E.fused(acc, cur, wr, wc, fr, fq, lds, wid, lane); S.done(cur); }
#undef PG8_SA
#undef PG8_SB
#undef PG8_STAGE
#undef PG8_LDA
#undef PG8_LDB
#undef PG8_MMA
#undef PG8_WAIT_V
#undef PG8_WAIT_L
#undef PG8_BAR
#undef PG8_SCHED
}
}

constexpr int NB = 16, SEQ = 2048, DM = 1024, CTXL = 256, LALL = SEQ + CTXL;
constexpr int ML = NB * SEQ, MC = NB * CTXL, MALL = ML + MC;
constexpr int NIN = 8192, NHEAD = 8;
constexpr float NORM_EPS = 1e-6f;
constexpr float LAM_INIT = 0.2f;

#define LAS __attribute__((address_space(3)))
typedef pg8::bf16_t bf16_t;
typedef pg8::bf16x8 bf16x8;
typedef pg8::f32x4 f32x4;
typedef pg8::u32x4 u32x4;
typedef float f32x16 __attribute__((ext_vector_type(16)));
typedef float f32x2 __attribute__((ext_vector_type(2)));
typedef unsigned u32x2 __attribute__((ext_vector_type(2)));
typedef short s16x4 __attribute__((ext_vector_type(4)));
typedef __bf16 bf16x2_t __attribute__((ext_vector_type(2)));

constexpr size_t MiB = 1u << 20;
constexpr size_t WS_MODF = 0;
constexpr size_t WS_ROPE = 256 * 1024;
constexpr size_t WS_BAR = 1 * MiB, WS_BAR_BYTES = 16384;
constexpr int LDS_BARW = 131072 + 64;
constexpr size_t WS_WIN = 2 * MiB;
constexpr size_t WS_WA = 18 * MiB, WS_WL = 20 * MiB, WS_WO = 22 * MiB;
constexpr size_t WS_XN = 24 * MiB;
constexpr size_t WS_Q = 96 * MiB;
constexpr size_t WS_GR = 160 * MiB;
constexpr size_t WS_GA = 224 * MiB;
constexpr size_t WS_KA = 288 * MiB;
constexpr size_t WS_VA = 360 * MiB;
constexpr size_t WS_T = 288 * MiB;
constexpr size_t WS_XR = 432 * MiB;
constexpr size_t WS_PART = 504 * MiB;
constexpr size_t WS_END = 506 * MiB;

constexpr int LDS_BYTES = 147456;

__device__ __forceinline__ unsigned pk_bf16(float lo, float hi) { f32x2 v = {lo, hi}; bf16x2_t b = __builtin_convertvector(v, bf16x2_t); return __builtin_bit_cast(unsigned, b); }
__device__ __forceinline__ float bf_lo(unsigned u) { return __uint_as_float(u << 16); }
__device__ __forceinline__ float bf_hi(unsigned u) { return __uint_as_float(u & 0xffff0000u); }
__device__ __forceinline__ float sigmoidf_(float v) { return __builtin_amdgcn_rcpf(1.0f + __builtin_amdgcn_exp2f(-1.4426950408889634f * v)); }
__device__ __forceinline__ float siluf_(float v) { return v * sigmoidf_(v); }
#define LDS_BARRIER() do { asm volatile("s_waitcnt lgkmcnt(0)" ::: "memory"); __builtin_amdgcn_s_barrier(); asm volatile("" ::: "memory"); } while (0)

struct InProjOrder {
    pg8::StaticOrder S; int G, c;
    __device__ void init(int G_, int c_) { S.init(ML, NIN, G_, c_); G = G_; c = c_; }
    __device__ bool next(int i, pg8::Unit& u) const {
        const long L = (long)i * G + c;
        if (L < 4096) return S.next(i, u);
        const int j = (int)(L - 4096); if (j >= 192) return false;
        u.pm = 128 + (j & 15); const int q = j >> 4; u.pn = q < 8 ? 4 + q : 8 + q;
        return true;
    }
    __device__ __forceinline__ void a_ready(const pg8::Unit&) const {}
    __device__ __forceinline__ void done(const pg8::Unit&) const {}
};

struct EpiInProj {
    static constexpr bool PERM = true, AFTER_DRAIN = false;
    __device__ __forceinline__ bool chain(const pg8::Unit&) const { return false; }
    bf16_t *Q, *KA, *VA, *GA, *XR, *GR, *GM; const f32x2* rope;
    __device__ __forceinline__ void operator()(const f32x4 (&acc)[2][2][4][2], const pg8::Unit& u, int wr, int wc, int fr, int fq) const {
        const int pn = u.pn, pm = u.pm;
        const bool lat = pm < 128;
        const int b = lat ? (pm >> 3) : (pm - 128);
        const int tb = lat ? ((pm & 7) << 8) : 0;
        const int seg = pn >> 2;
        bf16_t* base; int pitch = 1024; size_t row0; int col0 = (pn & 3) * 256; int mode = 0;
        const size_t rowL = (size_t)b * SEQ + tb, rowA = (size_t)b * LALL + (lat ? CTXL : 0) + tb;
        float qs = 1.0f;
        if (seg == 0) { base = Q; row0 = rowL; mode = 1; qs = 0.125f * 1.4426950408889634f; }
        else if (seg == 1) { base = KA; row0 = rowA; mode = lat ? 1 : 0; }
        else if (seg == 2) { base = VA; row0 = rowA; }
        else if (seg == 3) { base = GA; row0 = rowL; }
        else if (seg == 4) { base = XR; row0 = rowA; }
        else if (seg == 5) { base = GR; row0 = rowL; }
        else { base = GM; pitch = 2048; row0 = rowL; col0 = (pn - 24) * 256; mode = 3; }
        const int lcol = wc * 32 + 8 * fq;
        const float sgn = (fq & 2) ? 1.0f : -1.0f;
#pragma unroll
        for (int ai = 0; ai < 2; ++ai)
#pragma unroll
            for (int m = 0; m < 4; ++m) {
                const int rloc = ai * 128 + wr * 64 + m * 16 + fr;
                bf16_t* rowp = base + (row0 + rloc) * (size_t)pitch + col0 + lcol;
                const int pos = (wc & 1) ? (m * 16 + fr) : ((tb >> 6) + 2 * ai + wr);
                const f32x4* rp = (const f32x4*)(rope + pos * 16 + 8 * (fq & 1));
#pragma unroll
                for (int bj = 0; bj < 2; ++bj) {
                    f32x4 v[2] = {acc[ai][bj][m][0], acc[ai][bj][m][1]};
                    if (mode == 1) {
#pragma unroll
                        for (int n = 0; n < 2; ++n) {
                            f32x4 p;
#pragma unroll
                            for (int i = 0; i < 4; ++i) p[i] = __shfl_xor(v[n][i], 32);
                            const f32x4 c0 = rp[2 * n], c1 = rp[2 * n + 1];
                            v[n][0] = (v[n][0] * c0[0] + sgn * p[0] * c0[1]) * qs;
                            v[n][1] = (v[n][1] * c0[2] + sgn * p[1] * c0[3]) * qs;
                            v[n][2] = (v[n][2] * c1[0] + sgn * p[2] * c1[1]) * qs;
                            v[n][3] = (v[n][3] * c1[2] + sgn * p[3] * c1[3]) * qs;
                            asm volatile("" ::: "memory");
                        }
                    } else if (mode == 2) {
#pragma unroll
                        for (int n = 0; n < 2; ++n)
#pragma unroll
                            for (int i = 0; i < 4; ++i) v[n][i] = siluf_(v[n][i]);
                    } else if (mode == 3) {
#pragma unroll
                        for (int n = 0; n < 2; ++n)
#pragma unroll
                            for (int i = 0; i < 4; ++i) v[n][i] = sigmoidf_(v[n][i]);
                    }
                    u32x4 w; w.x = pk_bf16(v[0][0], v[0][1]); w.y = pk_bf16(v[0][2], v[0][3]); w.z = pk_bf16(v[1][0], v[1][1]); w.w = pk_bf16(v[1][2], v[1][3]);
                    *(u32x4*)(rowp + bj * 128) = w;
                }
                asm volatile("" ::: "memory");
            }
    }
};

struct PairOrder {
    pg8::StaticOrder S;
    __device__ void init(int G_, int c_) { S.init(ML, 1024, G_, c_); }
    __device__ bool next(int i, pg8::Unit& u) const { if (!S.next(i >> 1, u)) return false; if (i & 1) { u.pm += 128; u.pn += 4; } return true; }
    __device__ __forceinline__ void a_ready(const pg8::Unit&) const {}
    __device__ __forceinline__ void done(const pg8::Unit&) const {}
};
struct EpiMerge {
    static constexpr bool PERM = true, AFTER_DRAIN = false;
    const bf16_t* GM; bf16_t* MB;
    __device__ __forceinline__ bool chain(const pg8::Unit& u) const { return u.pm < 128; }
    __device__ __forceinline__ void operator()(f32x4 (&acc)[2][2][4][2], const pg8::Unit& u, int wr, int wc, int fr, int fq) const {
        const bool first = u.pm < 128;
        const int pm = first ? u.pm : u.pm - 128, pn = first ? u.pn : u.pn - 4;
#pragma unroll
        for (int ai = 0; ai < 2; ++ai)
#pragma unroll
            for (int m = 0; m < 4; ++m) {
                const size_t row = (size_t)pm * 256 + ai * 128 + wr * 64 + m * 16 + fr;
#pragma unroll
                for (int bj = 0; bj < 2; ++bj) {
                    const int col = pn * 256 + bj * 128 + wc * 32 + 8 * fq;
                    const u32x4 gl = *(const u32x4*)(GM + row * 2048 + 1024 + col);
                    float ml[8] = {bf_lo(gl.x), bf_hi(gl.x), bf_lo(gl.y), bf_hi(gl.y), bf_lo(gl.z), bf_hi(gl.z), bf_lo(gl.w), bf_hi(gl.w)};
                    if (first) {
                        const u32x4 ga = *(const u32x4*)(GM + row * 2048 + col);
                        const float ma[8] = {bf_lo(ga.x), bf_hi(ga.x), bf_lo(ga.y), bf_hi(ga.y), bf_lo(ga.z), bf_hi(ga.z), bf_lo(ga.w), bf_hi(ga.w)};
#pragma unroll
                        for (int i = 0; i < 4; ++i) { acc[ai][bj][m][0][i] *= ma[i] * __builtin_amdgcn_rcpf(fmaxf(ml[i], 1e-30f)); acc[ai][bj][m][1][i] *= ma[4 + i] * __builtin_amdgcn_rcpf(fmaxf(ml[4 + i], 1e-30f)); }
                    } else {
                        const f32x4 a0 = acc[ai][bj][m][0], a1 = acc[ai][bj][m][1];
                        u32x4 w; w.x = pk_bf16(a0[0] * ml[0], a0[1] * ml[1]); w.y = pk_bf16(a0[2] * ml[2], a0[3] * ml[3]); w.z = pk_bf16(a1[0] * ml[4], a1[1] * ml[5]); w.w = pk_bf16(a1[2] * ml[6], a1[3] * ml[7]);
                        *(u32x4*)(MB + row * 1024 + col) = w;
                    }
                }
                asm volatile("" ::: "memory");
            }
    }
};
struct EpiOut {
    static constexpr bool PERM = true, AFTER_DRAIN = false;
    __device__ __forceinline__ bool chain(const pg8::Unit&) const { return false; }
    bf16_t* Y; float* PART;
    __device__ __forceinline__ void operator()(const f32x4 (&acc)[2][2][4][2], const pg8::Unit& u, int wr, int wc, int fr, int fq) const {
#pragma unroll
        for (int ai = 0; ai < 2; ++ai)
#pragma unroll
            for (int m = 0; m < 4; ++m) {
                const size_t row = (size_t)u.pm * 256 + ai * 128 + wr * 64 + m * 16 + fr;
                float ss = 0.f;
#pragma unroll
                for (int bj = 0; bj < 2; ++bj) {
                    const int col = u.pn * 256 + bj * 128 + wc * 32 + 8 * fq;
                    const f32x4 a0 = acc[ai][bj][m][0], a1 = acc[ai][bj][m][1];
                    u32x4 w; w.x = pk_bf16(a0[0], a0[1]); w.y = pk_bf16(a0[2], a0[3]); w.z = pk_bf16(a1[0], a1[1]); w.w = pk_bf16(a1[2], a1[3]);
                    *(u32x4*)(Y + row * 1024 + col) = w;
                    ss += (a0[0] * a0[0] + a0[1] * a0[1]) + (a0[2] * a0[2] + a0[3] * a0[3]) + (a1[0] * a1[0] + a1[1] * a1[1]) + (a1[2] * a1[2] + a1[3] * a1[3]);
                }
                ss += __shfl_xor(ss, 16); ss += __shfl_xor(ss, 32);
                if (fq == 0) PART[row * 16 + u.pn * 4 + wc] = ss;
            }
    }
};

struct Params {
    const float *x, *c, *ctx, *c_ctx, *w_mod, *b_mod, *g_pre, *g_post, *w_in, *lq1, *lk1, *lq2, *lk2, *g_subln, *w_attn_out, *conv_w, *conv_b,
                *w_rg_a, *b_rg_a, *w_rg_x, *b_rg_x, *lru_lambda, *w_lru_out, *w_out;
    float* out; unsigned char* ws;
};

typedef const __attribute__((address_space(4))) Params* KP;

__device__ __forceinline__ float wave_sum(float v) {
#pragma unroll
    for (int o = 1; o < 64; o <<= 1) v += __shfl_xor(v, o);
    return v;
}

__device__ __forceinline__ void transpose_item(const float* W, int K, int N, bf16_t* WT, LAS float* scr, int item, int lane) {
    const int nblk = N / 32, kb = item / nblk, nb = item % nblk, k0 = 64 * kb, n0 = 32 * nb;
#pragma unroll 8
    for (int i = 0; i < 32; ++i) { const int kk = 2 * i + (lane >> 5); scr[kk * 33 + (lane & 31)] = W[(size_t)(k0 + kk) * N + n0 + (lane & 31)]; }
    asm volatile("s_waitcnt lgkmcnt(0)" ::: "memory");
    const int c = lane & 7;
#pragma unroll
    for (int j = 0; j < 4; ++j) { const int n = (lane >> 3) + 8 * j; const LAS float* s = scr + (8 * c) * 33 + n;
        u32x4 o; o.x = pk_bf16(s[0 * 33], s[1 * 33]); o.y = pk_bf16(s[2 * 33], s[3 * 33]); o.z = pk_bf16(s[4 * 33], s[5 * 33]); o.w = pk_bf16(s[6 * 33], s[7 * 33]);
        *(u32x4*)(WT + (size_t)(n0 + n) * K + k0 + 8 * c) = o; }
    asm volatile("s_waitcnt lgkmcnt(0)" ::: "memory");
}

__device__ __forceinline__ void phase0a(KP P, unsigned char* lds, int tid, int wid, int lane) {
    unsigned char* ws = P->ws;
    const int G = gridDim.x, bx = blockIdx.x;
    for (int item = bx; item < 192; item += G) {
        float* s = (float*)lds;
        float* red = (float*)(lds + 17 * 1024 * 4);
        for (int idx = tid; idx < 17 * 1024; idx += 512) { const int bb = idx >> 10, k = idx & 1023; const float v = bb < 16 ? P->c[bb * 1024 + k] : P->c_ctx[k]; s[idx] = siluf_(v); }
        __syncthreads();
        const int col = lane & 15, ksub = lane >> 4, n = item * 16 + col, k0 = wid * 128 + ksub * 32;
        float acc[17];
#pragma unroll
        for (int bb = 0; bb < 17; ++bb) acc[bb] = 0.f;
#pragma unroll 4
        for (int k = k0; k < k0 + 32; ++k) {
            const float w = P->w_mod[(size_t)k * 3072 + n];
#pragma unroll
            for (int bb = 0; bb < 17; ++bb) acc[bb] += s[bb * 1024 + k] * w;
        }
#pragma unroll
        for (int bb = 0; bb < 17; ++bb) red[((wid * 4 + ksub) * 17 + bb) * 16 + col] = acc[bb];
        __syncthreads();
        float* MODF = (float*)(ws + WS_MODF);
        for (int idx = tid; idx < 17 * 16; idx += 512) {
            const int bb = idx >> 4, l = idx & 15; float sum = 0.f;
#pragma unroll
            for (int w = 0; w < 32; ++w) sum += red[(w * 17 + bb) * 16 + l];
            MODF[bb * 3072 + item * 16 + l] = sum + P->b_mod[item * 16 + l];
        }
        __syncthreads();
    }
    if (bx == (200 % G)) {
        f32x2* rope = (f32x2*)(ws + WS_ROPE);
        for (int idx = tid; idx < 1024; idx += 512) {
            const int pos = idx >> 4, f = idx & 15;
            const float inv = powf(10000.0f, -(float)(2 * f) / 32.0f);
            const float ang = (float)pos * inv;
            rope[idx] = (f32x2){cosf(ang), sinf(ang)};
        }
    }
    LAS float* scr = (LAS float*)((LAS unsigned char*)lds + wid * 16384);
    const int gw = bx * 8 + wid, NGW = G * 8;
    constexpr int I_IN = 16 * 256, I_SQ = 16 * 32;
    for (int it = gw; it < I_IN + 3 * I_SQ; it += NGW) {
        int r = it;
        if (r < I_IN) { transpose_item(P->w_in, 1024, NIN, (bf16_t*)(ws + WS_WIN), scr, r, lane); continue; } r -= I_IN;
        if (r < I_SQ) { transpose_item(P->w_attn_out, 1024, 1024, (bf16_t*)(ws + WS_WA), scr, r, lane); continue; } r -= I_SQ;
        if (r < I_SQ) { transpose_item(P->w_lru_out, 1024, 1024, (bf16_t*)(ws + WS_WL), scr, r, lane); continue; } r -= I_SQ;
        transpose_item(P->w_out, 1024, 1024, (bf16_t*)(ws + WS_WO), scr, r, lane);
    }
}

__device__ __forceinline__ void phase0b(KP P, int wid, int lane) {
    const float* MODF = (const float*)(P->ws + WS_MODF);
    bf16_t* XN = (bf16_t*)(P->ws + WS_XN);
    const int gw = blockIdx.x * 8 + wid, NGW = gridDim.x * 8;
    const int per = (MALL + NGW - 1) / NGW;
    int r0 = gw * per, r1 = r0 + per; if (r1 > MALL) r1 = MALL;
    f32x4 g[4], sc[4], sh[4];
#pragma unroll
    for (int j = 0; j < 4; ++j) g[j] = *(const f32x4*)(P->g_pre + 4 * lane + 256 * j);
    int cur = -1;
    for (int row = r0; row < r1; ++row) {
        const int bb = row < ML ? (row >> 11) : 16;
        if (bb != cur) {
            cur = bb;
#pragma unroll
            for (int j = 0; j < 4; ++j) { sh[j] = *(const f32x4*)(MODF + bb * 3072 + 4 * lane + 256 * j); sc[j] = *(const f32x4*)(MODF + bb * 3072 + 1024 + 4 * lane + 256 * j);
                sc[j] = (sc[j] + 1.0f) * g[j]; }
        }
        const float* xr = row < ML ? P->x + (size_t)row * 1024 : P->ctx + (size_t)(row - ML) * 1024;
        f32x4 v[4]; float s = 0.f;
#pragma unroll
        for (int j = 0; j < 4; ++j) { v[j] = *(const f32x4*)(xr + 4 * lane + 256 * j); s += (v[j][0] * v[j][0] + v[j][1] * v[j][1]) + (v[j][2] * v[j][2] + v[j][3] * v[j][3]); }
        const float rstd = rsqrtf(wave_sum(s) * (1.0f / 1024.0f) + NORM_EPS);
#pragma unroll
        for (int j = 0; j < 4; ++j) {
            const f32x4 o = v[j] * rstd * sc[j] + sh[j];
            u32x2 w; w.x = pk_bf16(o[0], o[1]); w.y = pk_bf16(o[2], o[3]);
            *(u32x2*)(XN + (size_t)row * 1024 + 4 * lane + 256 * j) = w;
        }
    }
}

constexpr int LRU_DIRB = 59392;
constexpr int LRU_XCF = 0;
constexpr int LRU_XCB = 16384;
constexpr int LRU_SA = 16384 + 9216;
constexpr int LRU_SU = LRU_SA + 4 * 1040 * 4;
constexpr int LRU_CARRY = LRU_SU + 4 * 1040 * 4;
constexpr int LRU_CW = 2 * LRU_DIRB;
static_assert(LRU_CARRY + 256 <= LRU_DIRB && LRU_CW + 5 * 64 * 4 <= 131072, "lru lds");

__device__ __forceinline__ void lru_unit(KP P, unsigned char* lds_g, bf16_t* ZLOUT, int b, int nb, int tid, int wid, int lane) {
    unsigned char* ws = P->ws;
    LAS unsigned char* lds = (LAS unsigned char*)lds_g;
    const bf16_t* XR = (const bf16_t*)(ws + WS_XR) + (size_t)b * LALL * 1024 + nb * 64;
    bf16_t* HF = (bf16_t*)(ws + WS_XN) + (size_t)b * SEQ * 1024 + nb * 64;
    const bf16_t* GRZ = (const bf16_t*)(ws + WS_GR) + (size_t)b * SEQ * 1024 + nb * 64;
    bf16_t* ZL = ZLOUT + (size_t)b * SEQ * 1024 + nb * 64;
    const int tok = tid >> 3, cc = tid & 7;
    const unsigned aoff = tok * 1024 + cc * 8;
    if (tid < 320) { const int j = tid >> 6, ch = tid & 63; ((LAS float*)(lds + LRU_CW))[tid] = j < 4 ? P->conv_w[j * 1024 + nb * 64 + ch] : P->conv_b[nb * 64 + ch]; }
    const LAS float* cwl = (const LAS float*)(lds + LRU_CW) + cc * 8;
    const int wdir = wid >> 2, w4 = wid & 3;
    LAS unsigned char* ldsd = lds + wdir * LRU_DIRB;
    const int tt = w4 & 1, nh = w4 >> 1, hh = lane >> 5, jch = nh * 32 + (lane & 31), chB = nb * 64 + jch;
    const int sc_c = 16 * w4 + (lane & 15), sc_seg = lane >> 4;
    bf16x8 wA[4], wX[4];
    {
        const float* wa = P->w_rg_a + (size_t)(wdir * 16 + nb) * 4096 + jch;
        const float* wx = P->w_rg_x + (size_t)(wdir * 16 + nb) * 4096 + jch;
#pragma unroll
        for (int ks = 0; ks < 4; ++ks) {
            unsigned ua[4], ux[4];
#pragma unroll
            for (int j2 = 0; j2 < 4; ++j2) {
                const int i0 = 16 * ks + 8 * hh + 2 * j2;
                ua[j2] = pk_bf16(wa[i0 * 64], wa[(i0 + 1) * 64]);
                ux[j2] = pk_bf16(wx[i0 * 64], wx[(i0 + 1) * 64]);
            }
            wA[ks] = __builtin_bit_cast(bf16x8, (u32x4){ua[0], ua[1], ua[2], ua[3]});
            wX[ks] = __builtin_bit_cast(bf16x8, (u32x4){ux[0], ux[1], ux[2], ux[3]});
        }
    }
    const float ba2 = -1.4426950408889634f * P->b_rg_a[wdir * 1024 + chB], bx2 = -1.4426950408889634f * P->b_rg_x[wdir * 1024 + chB];
    const float sp8 = -8.0f * 1.4426950408889634f * log1pf(__expf(-P->lru_lambda[wdir * 1024 + chB]));
    if (tid < 64) { ((LAS float*)(lds + LRU_CARRY))[tid] = 0.f; ((LAS float*)(lds + LRU_DIRB + LRU_CARRY))[tid] = 0.f; }
    u32x4 xr[2][4];
#define LRU_LOAD_XR(IT) do { const int cf_ = (IT), cb_ = (IT) < 4 ? 3 - (IT) : 39 - (IT); \
        _Pragma("unroll") for (int d = 0; d < 2; ++d) { const int ci = d ? cb_ : cf_, lo = ci < 4 ? 0 : CTXL, hi = ci < 4 ? CTXL : LALL; \
            _Pragma("unroll") for (int j = 0; j < 4; ++j) { const int pp = ci * 64 + tok - 1 + j; xr[d][j] = (u32x4){0u, 0u, 0u, 0u}; \
                if (pp >= lo && pp < hi) xr[d][j] = *(const u32x4*)(XR + (ptrdiff_t)(ci * 64 - 1 + j) * 1024 + aoff); } } } while (0)
    LRU_LOAD_XR(0);
    __syncthreads();
#pragma unroll 1
    for (int it = 0; it < 36; ++it) {
        const int cf = it, cb = it < 4 ? 3 - it : 39 - it;
        {
            float xc[2][8];
            { const f32x4 c0 = *(const LAS f32x4*)(cwl + 256), c1 = *(const LAS f32x4*)(cwl + 260);
#pragma unroll
              for (int d = 0; d < 2; ++d) { xc[d][0] = c0[0]; xc[d][1] = c0[1]; xc[d][2] = c0[2]; xc[d][3] = c0[3]; xc[d][4] = c1[0]; xc[d][5] = c1[1]; xc[d][6] = c1[2]; xc[d][7] = c1[3]; } }
#pragma unroll
            for (int j = 0; j < 4; ++j) {
                const f32x4 w0 = *(const LAS f32x4*)(cwl + j * 64), w1 = *(const LAS f32x4*)(cwl + j * 64 + 4);
#pragma unroll
                for (int d = 0; d < 2; ++d) {
                    const u32x4 v = xr[d][j];
                    xc[d][0] += w0[0] * bf_lo(v.x); xc[d][1] += w0[1] * bf_hi(v.x); xc[d][2] += w0[2] * bf_lo(v.y); xc[d][3] += w0[3] * bf_hi(v.y);
                    xc[d][4] += w1[0] * bf_lo(v.z); xc[d][5] += w1[1] * bf_hi(v.z); xc[d][6] += w1[2] * bf_lo(v.w); xc[d][7] += w1[3] * bf_hi(v.w);
                }
            }
#pragma unroll
            for (int d = 0; d < 2; ++d) {
                LAS float* XCF = (LAS float*)(lds + d * LRU_DIRB + LRU_XCF);
                LAS unsigned char* XCB = lds + d * LRU_DIRB + LRU_XCB;
                *(LAS f32x4*)(XCF + tok * 64 + cc * 8) = (f32x4){xc[d][0], xc[d][1], xc[d][2], xc[d][3]};
                *(LAS f32x4*)(XCF + tok * 64 + cc * 8 + 4) = (f32x4){xc[d][4], xc[d][5], xc[d][6], xc[d][7]};
                u32x4 w; w.x = pk_bf16(xc[d][0], xc[d][1]); w.y = pk_bf16(xc[d][2], xc[d][3]); w.z = pk_bf16(xc[d][4], xc[d][5]); w.w = pk_bf16(xc[d][6], xc[d][7]);
                *(LAS u32x4*)(XCB + tok * 144 + cc * 16) = w;
            }
        }
        if (it + 1 < 36) LRU_LOAD_XR(it + 1);
        u32x4 stg[2], stf[2];
#pragma unroll
        for (int d = 0; d < 2; ++d) {
            const int ci = d ? cb : cf; const bool first = d ? (ci >= 20) : (ci <= 19);
            stg[d] = (u32x4){0u, 0u, 0u, 0u}; stf[d] = stg[d];
            if (ci >= 4 && !first) { const size_t off = (size_t)(ci * 64 - CTXL) * 1024 + aoff; stg[d] = *(const u32x4*)(GRZ + off); stf[d] = *(const u32x4*)(HF + off); }
        }
        LDS_BARRIER();
        {
            const LAS unsigned char* XCB = ldsd + LRU_XCB;
            f32x16 accA = {}, accX = {};
#pragma unroll
            for (int ks = 0; ks < 4; ++ks) {
                const bf16x8 af = *(const LAS bf16x8*)(XCB + (32 * tt + (lane & 31)) * 144 + (16 * ks + 8 * hh) * 2);
                accA = __builtin_amdgcn_mfma_f32_32x32x16_bf16(af, wA[ks], accA, 0, 0, 0);
                accX = __builtin_amdgcn_mfma_f32_32x32x16_bf16(af, wX[ks], accX, 0, 0, 0);
            }
            const int sbase = wdir == 0 ? (2 * tt * 1040 + 4 * hh * 64 + jch) : ((3 - 2 * tt) * 1040 + (15 - 4 * hh) * 64 + jch - 1744);
            const LAS float* xcf = (const LAS float*)(ldsd + LRU_XCF) + (32 * tt + 4 * hh) * 64 + jch;
            LAS float* SA = (LAS float*)(ldsd + LRU_SA) + sbase;
            LAS float* SU = (LAS float*)(ldsd + LRU_SU) + sbase;
            float av[16], uv[16];
#pragma unroll
            for (int r = 0; r < 16; ++r) {
                const float ra = __builtin_amdgcn_rcpf(1.0f + __builtin_amdgcn_exp2f(accA[r] * -1.4426950408889634f + ba2));
                const float ix = __builtin_amdgcn_rcpf(1.0f + __builtin_amdgcn_exp2f(accX[r] * -1.4426950408889634f + bx2));
                av[r] = __builtin_amdgcn_exp2f(sp8 * ra);
                uv[r] = __builtin_amdgcn_sqrtf(1.0f - av[r] * av[r]) * ix * xcf[(8 * (r >> 2) + (r & 3)) * 64];
            }
            if (wdir == 0) {
#pragma unroll
                for (int r = 0; r < 16; ++r) { const int cr = (r >> 3) * 1040 + (8 * ((r >> 2) & 1) + (r & 3)) * 64; SA[cr] = av[r]; SU[cr] = uv[r]; }
            } else {
#pragma unroll
                for (int r = 0; r < 16; ++r) { const int cr = (r >> 3) * 1040 + (8 * ((r >> 2) & 1) + (r & 3)) * 64; SA[1744 - cr] = av[r]; SU[1744 - cr] = uv[r]; }
            }
        }
        LDS_BARRIER();
        {
            LAS float* SA = (LAS float*)(ldsd + LRU_SA) + sc_seg * 1040 + sc_c;
            LAS float* SU = (LAS float*)(ldsd + LRU_SU) + sc_seg * 1040 + sc_c;
            LAS float* CARRY = (LAS float*)(ldsd + LRU_CARRY);
            float A = 1.f, U = 0.f;
#pragma unroll
            for (int s2 = 0; s2 < 16; ++s2) { const float a_ = SA[s2 * 64], u_ = SU[s2 * 64]; U = a_ * U + u_; A *= a_; }
#pragma unroll
            for (int d = 16; d < 64; d <<= 1) {
                const float Ap = __shfl_up(A, d), Up = __shfl_up(U, d);
                if (lane >= d) { U = A * Up + U; A = A * Ap; }
            }
            float Ae = __shfl_up(A, 16), Ue = __shfl_up(U, 16);
            if (sc_seg == 0) { Ae = 1.f; Ue = 0.f; }
            const float hc = CARRY[sc_c];
            float h = Ae * hc + Ue;
            if (sc_seg == 3) CARRY[sc_c] = A * hc + U;
#pragma unroll
            for (int s2 = 0; s2 < 16; ++s2) { h = SA[s2 * 64] * h + SU[s2 * 64]; SU[s2 * 64] = h; }
        }
        LDS_BARRIER();
#pragma unroll
        for (int d = 0; d < 2; ++d) {
            const int ci = d ? cb : cf;
            if (ci >= 4) {
                const int tau = d ? 63 - tok : tok;
                const LAS float* SU = (const LAS float*)(lds + d * LRU_DIRB + LRU_SU) + (tau >> 4) * 1040 + (tau & 15) * 64 + cc * 8;
                const f32x4 h0 = *(const LAS f32x4*)SU, h1 = *(const LAS f32x4*)(SU + 4);
                const size_t off = (size_t)(ci * 64 - CTXL) * 1024 + aoff;
                const bool first = d ? (ci >= 20) : (ci <= 19);
                if (first) {
                    u32x4 w; w.x = pk_bf16(h0[0], h0[1]); w.y = pk_bf16(h0[2], h0[3]); w.z = pk_bf16(h1[0], h1[1]); w.w = pk_bf16(h1[2], h1[3]);
                    *(u32x4*)(HF + off) = w;
                } else {
                    const u32x4 f = stf[d], g = stg[d];
                    u32x4 w;
                    w.x = pk_bf16((bf_lo(f.x) + h0[0]) * siluf_(bf_lo(g.x)), (bf_hi(f.x) + h0[1]) * siluf_(bf_hi(g.x)));
                    w.y = pk_bf16((bf_lo(f.y) + h0[2]) * siluf_(bf_lo(g.y)), (bf_hi(f.y) + h0[3]) * siluf_(bf_hi(g.y)));
                    w.z = pk_bf16((bf_lo(f.z) + h1[0]) * siluf_(bf_lo(g.z)), (bf_hi(f.z) + h1[1]) * siluf_(bf_hi(g.z)));
                    w.w = pk_bf16((bf_lo(f.w) + h1[2]) * siluf_(bf_lo(g.w)), (bf_hi(f.w) + h1[3]) * siluf_(bf_hi(g.w)));
                    *(u32x4*)(ZL + off) = w;
                }
            }
        }
    }
    __syncthreads();
}

constexpr int ATT_KSLOT = 8192, ATT_V0 = 3 * 8192, ATT_VBUF = 16384, ATT_STASH = ATT_V0 + 2 * ATT_VBUF;
__device__ __forceinline__ s16x4 vtr(const LAS unsigned char* p) { return __builtin_bit_cast(s16x4, __builtin_amdgcn_ds_read_tr16_b64_v4i16((LAS s16x4*)p)); }

__device__ __forceinline__ void attn_qk(const LAS unsigned char* lds, int kcur, const int (&kaddr)[4], const bf16x8 (&qf)[4], const f32x16& cinit, f32x16& p0, f32x16& p1) {
    p0 = cinit; p1 = cinit;
#pragma unroll
    for (int ks = 0; ks < 4; ++ks) {
        const bf16x8 k0 = *(const LAS bf16x8*)(lds + kcur + kaddr[ks]);
        const bf16x8 k1 = *(const LAS bf16x8*)(lds + kcur + kaddr[ks] + 4096);
        p0 = __builtin_amdgcn_mfma_f32_32x32x16_bf16(k0, qf[ks], p0, 0, 0, 0);
        p1 = __builtin_amdgcn_mfma_f32_32x32x16_bf16(k1, qf[ks], p1, 0, 0, 0);
    }
}
__device__ __forceinline__ void attn_tile(const LAS unsigned char* lds, int knext, int vcur, const int (&kaddr)[4], const int (&vaddr)[4], const bf16x8 (&qf)[4],
                                          f32x16& p0, f32x16& p1, f32x16& pn0, f32x16& pn1, f32x16 (&o)[4], float& m_ref, float& l, float& mx, f32x16& negm) {
    constexpr float THR = 8.0f;
    if (__builtin_amdgcn_ballot_w64(mx > m_ref + THR) != 0ull) {
        const float mf = fmaxf(mx, __shfl_xor(mx, 32));
        if (mf > m_ref + THR) {
            const float delta = mf - m_ref, alpha = __builtin_amdgcn_exp2f(-delta);
            l *= alpha;
#pragma unroll
            for (int d = 0; d < 4; ++d) o[d] = o[d] * alpha;
            p0 = p0 - delta; p1 = p1 - delta;
            m_ref = mf;
#pragma unroll
            for (int r = 0; r < 16; ++r) negm[r] = -mf;
        }
    }
    attn_qk(lds, knext, kaddr, qf, negm, pn0, pn1);
    unsigned pa[4][4];
    float ls = 0.f;
#pragma unroll
    for (int r = 0; r < 16; r += 2) {
        const float e0 = __builtin_amdgcn_exp2f(p0[r]), e1 = __builtin_amdgcn_exp2f(p0[r + 1]);
        const float f0 = __builtin_amdgcn_exp2f(p1[r]), f1 = __builtin_amdgcn_exp2f(p1[r + 1]);
        ls += (e0 + e1) + (f0 + f1);
        pa[r >> 3][(r & 7) >> 1] = pk_bf16(e0, e1);
        pa[2 + (r >> 3)][(r & 7) >> 1] = pk_bf16(f0, f1);
    }
    l += ls;
    {
        float mn = pn0[0];
#pragma unroll
        for (int r = 1; r < 16; ++r) mn = fmaxf(mn, pn0[r]);
#pragma unroll
        for (int r = 0; r < 16; ++r) mn = fmaxf(mn, pn1[r]);
        mx = mn + m_ref;
    }
    bf16x8 vf[2][4];
#define ATT_LDV(S, BUF) do { _Pragma("unroll") for (int dvt = 0; dvt < 4; ++dvt) { \
        const s16x4 lo = vtr(lds + vcur + vaddr[dvt] + (S) * 4096), hh2 = vtr(lds + vcur + vaddr[dvt] + (S) * 4096 + 2048); \
        vf[BUF][dvt] = (bf16x8){lo[0], lo[1], lo[2], lo[3], hh2[0], hh2[1], hh2[2], hh2[3]}; } } while (0)
    ATT_LDV(0, 0);
#pragma unroll
    for (int s = 0; s < 4; ++s) {
        if (s < 3) ATT_LDV(s + 1, (s + 1) & 1);
        const bf16x8 pb = __builtin_bit_cast(bf16x8, (u32x4){pa[s][0], pa[s][1], pa[s][2], pa[s][3]});
#pragma unroll
        for (int dvt = 0; dvt < 4; ++dvt) o[dvt] = __builtin_amdgcn_mfma_f32_32x32x16_bf16(vf[s & 1][dvt], pb, o[dvt], 0, 0, 0);
    }
#undef ATT_LDV
}

__device__ __forceinline__ void attn_unit(KP P, unsigned char* lds_g, bf16_t* ZOUT, int b, int h, int qb, float lam, int tid, int wid, int lane) {
    unsigned char* ws = P->ws;
    LAS unsigned char* lds = (LAS unsigned char*)lds_g;
    bf16_t* QZ = (bf16_t*)(ws + WS_Q);
    const bf16_t* KA = (const bf16_t*)(ws + WS_KA);
    const bf16_t* VA = (const bf16_t*)(ws + WS_VA);
    const bf16_t* GA = (const bf16_t*)(ws + WS_GA);
    const int q = lane & 31, hi = lane >> 5;
    const size_t qrow_u = ((size_t)b * SEQ + qb * 256 + wid * 32) * 1024 + h * 128;
    const unsigned qoff = q * 1024 + 8 * hi;
    constexpr float C2 = 0.125f * 1.4426950408889634f;
    constexpr float THR = 8.0f;
    unsigned koff; unsigned voff[2];
    { const int row = 8 * wid + (lane >> 3), pc = lane & 7; koff = row * 1024 + (pc ^ ((row >> 1) & 7)) * 8; }
#pragma unroll
    for (int i = 0; i < 2; ++i) { const int row = 4 * (2 * wid + i) + (lane >> 4), pc = lane & 15, c = (((pc >> 2) ^ (row & 3)) << 2) | (pc & 3); voff[i] = row * 1024 + c * 8; }
    const int kpiece = wid * 1024, vpiece = ATT_V0 + wid * 2048;
#define ATT_DMA(G, L) do { unsigned keep_; const void* g_ = (const void*)(G); const unsigned l_ = (unsigned)__builtin_amdgcn_readfirstlane((int)(unsigned)(uintptr_t)(L)); \
        asm volatile("s_mov_b32 %0, m0\n\ts_mov_b32 m0, %2\n\ts_nop 0\n\tglobal_load_lds_dwordx4 %1, off\n\ts_mov_b32 m0, %0" : "=&s"(keep_) : "v"(g_), "s"(l_) : "memory"); } while (0)
    int kaddr[4];
#pragma unroll
    for (int ks = 0; ks < 4; ++ks) kaddr[ks] = q * 128 + 16 * ((2 * ks + hi) ^ ((q >> 1) & 7));
    int vaddr[4];
    { const int g = lane >> 4, qq = (lane >> 2) & 3, pp = lane & 3, h2 = g >> 1;
#pragma unroll
      for (int dvt = 0; dvt < 4; ++dvt) vaddr[dvt] = ATT_V0 + (4 * h2 + qq) * 256 + ((dvt ^ qq) * 64) + (g & 1) * 32 + pp * 8; }

    LAS unsigned* o1s = (LAS unsigned*)(lds + ATT_STASH + wid * 8192) + lane;
    const bf16_t* Kb = KA + (size_t)b * LALL * 1024 + h * 128;
    const bf16_t* Vb = VA + (size_t)b * LALL * 1024 + h * 128;

#pragma unroll 1
    for (int pass = 0; pass < 2; ++pass) {
        bf16x8 qf[4];
#pragma unroll
        for (int ks = 0; ks < 4; ++ks) qf[ks] = *(const bf16x8*)(QZ + qrow_u + pass * 64 + 16 * ks + qoff);
        const bf16_t* Kp = Kb + pass * 64;
        f32x16 o[4];
#pragma unroll
        for (int d = 0; d < 4; ++d) o[d] = (f32x16){};
        float m_ref = -1e30f, l = 0.f;
        {
            ATT_DMA(Kp + koff, lds + kpiece); ATT_DMA(Kp + 65536 + koff, lds + ATT_KSLOT + kpiece);
            ATT_DMA(Vb + voff[0], lds + vpiece); ATT_DMA(Vb + voff[1], lds + vpiece + 1024);
            asm volatile("s_waitcnt vmcnt(0)" ::: "memory");
        }
        __syncthreads();
        asm volatile("" :: "v"(qf[0]), "v"(qf[1]), "v"(qf[2]), "v"(qf[3]));
        f32x16 pa0, pa1, pb0, pb1, negm = {};
        attn_qk(lds, 0, kaddr, qf, negm, pa0, pa1);
        float mxc = pa0[0];
#pragma unroll
        for (int r = 1; r < 16; ++r) mxc = fmaxf(mxc, pa0[r]);
#pragma unroll
        for (int r = 0; r < 16; ++r) mxc = fmaxf(mxc, pa1[r]);
        m_ref = fmaxf(mxc, __shfl_xor(mxc, 32));
        pa0 = pa0 - m_ref; pa1 = pa1 - m_ref;
#pragma unroll
        for (int r = 0; r < 16; ++r) negm[r] = -m_ref;
        int ks1 = ATT_KSLOT, ks2 = 2 * ATT_KSLOT;
#define ATT_STEP(T, PC0, PC1, PN0, PN1, VCUR, VNXT) do { \
            const size_t rk = (size_t)((T) + 2 < LALL / 64 ? (T) + 2 : LALL / 64 - 1) * 65536, rv = (size_t)((T) + 1 < LALL / 64 ? (T) + 1 : LALL / 64 - 1) * 65536; \
            ATT_DMA(Kp + rk + koff, lds + ks2 + kpiece); ATT_DMA(Vb + rv + voff[0], lds + (VNXT) + vpiece); ATT_DMA(Vb + rv + voff[1], lds + (VNXT) + vpiece + 1024); \
            attn_tile(lds, ks1, (VCUR), kaddr, vaddr, qf, PC0, PC1, PN0, PN1, o, m_ref, l, mxc, negm); \
            asm volatile("s_waitcnt vmcnt(0)" ::: "memory"); \
            { const int k3 = ks1 + ks2 == 3 * ATT_KSLOT ? 0 : (ks1 + ks2 == ATT_KSLOT ? 2 * ATT_KSLOT : ATT_KSLOT); ks1 = ks2; ks2 = k3; } \
            __syncthreads(); } while (0)
#pragma unroll 1
        for (int t = 0; t < LALL / 64; t += 2) {
            ATT_STEP(t, pa0, pa1, pb0, pb1, 0, ATT_VBUF);
            ATT_STEP(t + 1, pb0, pb1, pa0, pa1, ATT_VBUF, 0);
        }
#undef ATT_STEP
        const float lt = l + __shfl_xor(l, 32);
        const float inv = 1.0f / lt;
        if (pass == 0) {
#pragma unroll
            for (int d = 0; d < 4; ++d)
#pragma unroll
                for (int r = 0; r < 16; r += 2) o1s[(d * 8 + (r >> 1)) * 64] = pk_bf16(o[d][r] * inv, o[d][r + 1] * inv);
        } else {
            const float li = lam * inv;
            float ss = 0.f;
#pragma unroll
            for (int d = 0; d < 4; ++d) {
#pragma unroll
                for (int r = 0; r < 16; r += 2) {
                    const unsigned o1 = o1s[(d * 8 + (r >> 1)) * 64];
                    const float a0 = bf_lo(o1) - li * o[d][r], a1 = bf_hi(o1) - li * o[d][r + 1];
                    ss += a0 * a0 + a1 * a1;
                }
                asm volatile("" ::: "memory");
            }
            ss += __shfl_xor(ss, 32);
            const float rstd = rsqrtf(ss * (1.0f / 128.0f) + NORM_EPS) * (1.0f - LAM_INIT);
            const unsigned eoff = q * 1024 + 8 * hi;
#pragma unroll
            for (int d = 0; d < 4; ++d)
#pragma unroll
                for (int pr = 0; pr < 2; ++pr) {
                    float va[4], vb[4];
#pragma unroll
                    for (int i = 0; i < 4; i += 2) {
                        const unsigned oa = o1s[(d * 8 + 4 * pr + (i >> 1)) * 64], ob = o1s[(d * 8 + 4 * pr + 2 + (i >> 1)) * 64];
                        va[i] = bf_lo(oa) - li * o[d][8 * pr + i]; va[i + 1] = bf_hi(oa) - li * o[d][8 * pr + i + 1];
                        vb[i] = bf_lo(ob) - li * o[d][8 * pr + 4 + i]; vb[i + 1] = bf_hi(ob) - li * o[d][8 * pr + 4 + i + 1];
                    }
#pragma unroll
                    for (int i = 0; i < 4; ++i) {
                        auto rr = __builtin_amdgcn_permlane32_swap(__float_as_uint(va[i]), __float_as_uint(vb[i]), false, false);
                        va[i] = __uint_as_float(rr[0]); vb[i] = __uint_as_float(rr[1]);
                    }
                    const int dv0 = 32 * d + 16 * pr + 8 * hi;
                    const f32x4 gs0 = *(const f32x4*)(P->g_subln + dv0), gs1 = *(const f32x4*)(P->g_subln + dv0 + 4);
                    const u32x4 ga = *(const u32x4*)(GA + qrow_u + 32 * d + 16 * pr + eoff);
                    u32x4 w;
                    w.x = pk_bf16(va[0] * rstd * gs0[0] * siluf_(bf_lo(ga.x)), va[1] * rstd * gs0[1] * siluf_(bf_hi(ga.x)));
                    w.y = pk_bf16(va[2] * rstd * gs0[2] * siluf_(bf_lo(ga.y)), va[3] * rstd * gs0[3] * siluf_(bf_hi(ga.y)));
                    w.z = pk_bf16(vb[0] * rstd * gs1[0] * siluf_(bf_lo(ga.z)), vb[1] * rstd * gs1[1] * siluf_(bf_hi(ga.z)));
                    w.w = pk_bf16(vb[2] * rstd * gs1[2] * siluf_(bf_lo(ga.w)), vb[3] * rstd * gs1[3] * siluf_(bf_hi(ga.w)));
                    *(u32x4*)(ZOUT + qrow_u + 32 * d + 16 * pr + eoff) = w;
                    asm volatile("" ::: "memory");
                }
        }
    }
}

__device__ __forceinline__ void phase4(KP P, int wid, int lane) {
    const float* MODF = (const float*)(P->ws + WS_MODF);
    const bf16_t* Y = (const bf16_t*)(P->ws + WS_T);
    const float* PART = (const float*)(P->ws + WS_PART);
    const int gw = blockIdx.x * 8 + wid, NGW = gridDim.x * 8;
    f32x4 gp[4];
#pragma unroll
    for (int j = 0; j < 4; ++j) gp[j] = *(const f32x4*)(P->g_post + 4 * lane + 256 * j);
    for (int row = gw; row < ML; row += NGW) {
        const int b = row >> 11;
        float ss = PART[(size_t)row * 16 + (lane & 15)];
        ss += __shfl_xor(ss, 1); ss += __shfl_xor(ss, 2); ss += __shfl_xor(ss, 4); ss += __shfl_xor(ss, 8);
        const float rstd = rsqrtf(ss * (1.0f / 1024.0f) + NORM_EPS);
#pragma unroll
        for (int j = 0; j < 4; ++j) {
            const int c = 4 * lane + 256 * j;
            const f32x4 xv = *(const f32x4*)(P->x + (size_t)row * 1024 + c);
            const u32x2 yb = *(const u32x2*)(Y + (size_t)row * 1024 + c);
            const f32x4 yv = (f32x4){bf_lo(yb.x), bf_hi(yb.x), bf_lo(yb.y), bf_hi(yb.y)};
            const f32x4 gt = *(const f32x4*)(MODF + b * 3072 + 2048 + c);
            *(f32x4*)(P->out + (size_t)row * 1024 + c) = xv + gt * (yv * rstd * gp[j]);
        }
    }
}

#define XB_TMO      128
#define XB_XCNT(j)  (256  + 64 * (j))
#define XB_XSUB(j)  (1280 + 64 * (j))
#define XB_XGEN(j)  (2304 + 64 * (j))
#define XB_TOP      3328
#define XB_TOPGEN   3392
#define XCD_BAR_WORDS 3456
#define XB_SPIN_CAP (1u << 18)

__device__ __forceinline__ unsigned xb_ld(unsigned* p)              { return __hip_atomic_load(p, __ATOMIC_RELAXED, __HIP_MEMORY_SCOPE_AGENT); }
__device__ __forceinline__ unsigned xb_add(unsigned* p, unsigned v) { return __hip_atomic_fetch_add(p, v, __ATOMIC_RELAXED, __HIP_MEMORY_SCOPE_AGENT); }
__device__ __forceinline__ unsigned xb_xcc_id() { return (unsigned)__builtin_amdgcn_s_getreg((3 << 11) | 20) & 0xFu; }
#define XB_SPIN(cond, bar) do { unsigned _sp = 0; while (cond) { __builtin_amdgcn_s_sleep(1); \
    if ((++_sp & 255u) == 0u) { if (xb_ld(&(bar)[XB_TMO])) break; if (_sp > XB_SPIN_CAP) { atomicAdd(&(bar)[XB_TMO], 1u); break; } } } } while (0)

struct XcdBarrier {
    unsigned* bar; unsigned x;
    volatile LAS unsigned* st;
};

__device__ __forceinline__ XcdBarrier xcd_barrier_post(unsigned* bar, volatile LAS unsigned* st) {
    XcdBarrier b; b.bar = bar; b.x = xb_xcc_id(); b.st = st;
    if (threadIdx.x == 0) (void)xb_add(&bar[XB_XCNT(b.x)], 1u);
    return b;
}
__device__ __forceinline__ void xcd_barrier_complete(unsigned* bar, unsigned x, unsigned& nloc, unsigned& nx) {
    const unsigned G = gridDim.x * gridDim.y * gridDim.z;
    unsigned sum, cnt, mine, sp = 0u;
    for (;;) {
        sum = 0u; cnt = 0u; mine = 0u;
#pragma unroll
        for (unsigned j = 0; j < 16; ++j) { const unsigned c = xb_ld(&bar[XB_XCNT(j)]); sum += c; cnt += (c > 0u) ? 1u : 0u; mine = (j == x) ? c : mine; }
        if (sum == G) break;
        __builtin_amdgcn_s_sleep(1);
        if ((++sp & 255u) == 0u) { if (xb_ld(&bar[XB_TMO])) break; if (sp > XB_SPIN_CAP) { atomicAdd(&bar[XB_TMO], 1u); break; } }
    }
    nloc = mine > 0u ? mine : 1u; nx = cnt > 0u ? cnt : 1u;
}

__device__ __forceinline__ void xcd_barrier(const XcdBarrier& b) {
    asm volatile("s_waitcnt vmcnt(0)" ::: "memory");
    __syncthreads();
    if (threadIdx.x == 0) {
        unsigned* bar = b.bar;
        __builtin_amdgcn_s_waitcnt(0);
        unsigned nloc = b.st[0], nx = b.st[1];
        if (nloc == 0u) { xcd_barrier_complete(bar, b.x, nloc, nx); b.st[0] = nloc; b.st[1] = nx; }
        const unsigned old = xb_add(&bar[XB_XSUB(b.x)], 1u);
        const unsigned gen = old / nloc;
        if (old + 1u == (gen + 1u) * nloc) {
            __builtin_amdgcn_fence(__ATOMIC_RELEASE, "agent");
            asm volatile("s_waitcnt vmcnt(0)" ::: "memory");
            const unsigned og = xb_add(&bar[XB_TOP], 1u);
            const unsigned tg = og / nx;
            if (og + 1u == (tg + 1u) * nx) xb_add(&bar[XB_TOPGEN], 1u);
            else XB_SPIN(xb_ld(&bar[XB_TOPGEN]) == tg, bar);
            __builtin_amdgcn_fence(__ATOMIC_ACQUIRE, "agent");
            xb_add(&bar[XB_XGEN(b.x)], 1u);
            asm volatile("s_waitcnt vmcnt(0)" ::: "memory");
        } else {
            XB_SPIN(xb_ld(&bar[XB_XGEN(b.x)]) == gen, bar);
            __builtin_amdgcn_fence(__ATOMIC_ACQUIRE, "agent");
            asm volatile("s_waitcnt vmcnt(0)" ::: "memory");
        }
    }
    __syncthreads();
}

__global__ void __launch_bounds__(512, 2) hybrid_fwd(Params Pval) {
    KP P = (KP)__builtin_amdgcn_kernarg_segment_ptr();
    extern __shared__ __attribute__((aligned(16))) unsigned char lds[];
    cg::grid_group grid = cg::this_grid();
#define FRESH_TID() int tid = threadIdx.x; asm volatile("" : "+v"(tid)); const int lane = tid & 63, wid = __builtin_amdgcn_readfirstlane(tid >> 6)
    const int G = gridDim.x, bx = blockIdx.x;
    unsigned char* ws = P->ws;
    if (threadIdx.x < 2) ((volatile LAS unsigned*)((LAS unsigned char*)lds + LDS_BARW))[threadIdx.x] = 0u;
    if (bx == 0) for (int i = threadIdx.x; i < (int)(WS_BAR_BYTES / 4); i += 512) __hip_atomic_store((unsigned*)(ws + WS_BAR) + i, 0u, __ATOMIC_RELAXED, __HIP_MEMORY_SCOPE_AGENT);
    __syncthreads();
    LAS unsigned char* ldsl = (LAS unsigned char*)lds;

#ifndef NO_P0A
    { FRESH_TID(); phase0a(P, lds, tid, wid, lane); }
#endif
    grid.sync();
    const XcdBarrier xbar = xcd_barrier_post((unsigned*)(ws + WS_BAR), (volatile LAS unsigned*)((LAS unsigned char*)lds + LDS_BARW));
#ifndef NO_P0B
    { FRESH_TID(); (void)tid; phase0b(P, wid, lane); }
#endif
    xcd_barrier(xbar);
#ifndef NO_P1
    {
        pg8::Gemm g{(const bf16_t*)(ws + WS_XN), (const bf16_t*)(ws + WS_WIN), MALL, NIN, 1024};
        InProjOrder S; S.init(G, bx);
        EpiInProj E{(bf16_t*)(ws + WS_Q), (bf16_t*)(ws + WS_KA), (bf16_t*)(ws + WS_VA), (bf16_t*)(ws + WS_GA), (bf16_t*)(ws + WS_XR), (bf16_t*)(ws + WS_GR), (bf16_t*)P->out,
                    (const f32x2*)(ws + WS_ROPE)};
        pg8::gemm_phase<EpiInProj, InProjOrder, true, true>(ldsl, g, S, E);
    }
#endif
    xcd_barrier(xbar);
    {
        const int vcu = (G % 8 == 0) ? (bx % 8) * (G / 8) + bx / 8 : bx;
#ifndef NO_LRU
        { FRESH_TID(); for (int u = vcu; u < 256; u += G) lru_unit(P, lds, (bf16_t*)(ws + WS_GR), u >> 4, u & 15, tid, wid, lane); }
#endif
#ifndef NO_ATT
        { FRESH_TID();
          float s1 = P->lq1[lane] * P->lk1[lane], s2 = P->lq2[lane] * P->lk2[lane];
          s1 = wave_sum(s1); s2 = wave_sum(s2);
          const float lam = __expf(s1) - __expf(s2) + LAM_INIT;
          for (int u = vcu; u < 1024; u += G) { const int bh = u >> 3; attn_unit(P, lds, (bf16_t*)(ws + WS_Q), bh >> 3, bh & 7, u & 7, lam, tid, wid, lane); } }
#endif
    }
    xcd_barrier(xbar);
#ifndef NO_P3A
    {
        PairOrder S; S.init(G, bx);
        pg8::Gemm g{(const bf16_t*)(ws + WS_Q), (const bf16_t*)(ws + WS_WA), 2 * ML, 2048, 1024};
        static_assert(WS_GR - WS_Q == (size_t)ML * 1024 * 2 && WS_WL - WS_WA == (size_t)1024 * 1024 * 2, "the second merge GEMM's operands must sit one full matrix behind the first's");
        EpiMerge E{(const bf16_t*)P->out, (bf16_t*)(ws + WS_XN)};
        pg8::gemm_phase<EpiMerge, PairOrder, true, true>(ldsl, g, S, E);
    }
#endif
    xcd_barrier(xbar);
#ifndef NO_P3B
    {
        pg8::StaticOrder S; S.init(ML, 1024, G, bx);
        pg8::Gemm g{(const bf16_t*)(ws + WS_XN), (const bf16_t*)(ws + WS_WO), ML, 1024, 1024};
        EpiOut E{(bf16_t*)(ws + WS_T), (float*)(ws + WS_PART)};
        pg8::gemm_phase<EpiOut, pg8::StaticOrder, true, true>(ldsl, g, S, E);
    }
#endif
    xcd_barrier(xbar);
#ifndef NO_P4
    { FRESH_TID(); (void)tid; phase4(P, wid, lane); }
#endif
}

extern "C" void kernel_launch(void* const* d_in, const int* in_sizes, int n_in, void* d_out, int out_size, void* d_ws, size_t ws_size, hipStream_t stream) {
    static int grid_blocks = 0;
    if (grid_blocks == 0) {
        if (n_in != 24 || out_size != ML * DM || ws_size < WS_END) { fprintf(stderr, "kernel_launch: unexpected problem (n_in %d out %d ws %zu)\n", n_in, out_size, ws_size); grid_blocks = -1; return; }
        int dev = 0, cus = 0, per_cu = 0;
        hipGetDevice(&dev);
        hipDeviceGetAttribute(&cus, hipDeviceAttributeMultiprocessorCount, dev);
        if (hipFuncSetAttribute((const void*)hybrid_fwd, hipFuncAttributeMaxDynamicSharedMemorySize, LDS_BYTES) != hipSuccess) { fprintf(stderr, "kernel_launch: hipFuncSetAttribute failed\n"); grid_blocks = -1; return; }
        if (hipOccupancyMaxActiveBlocksPerMultiprocessor(&per_cu, (const void*)hybrid_fwd, 512, LDS_BYTES) != hipSuccess || per_cu < 1) { fprintf(stderr, "kernel_launch: occupancy query failed (%d)\n", per_cu); (void)hipGetLastError(); per_cu = 1; }
        grid_blocks = cus;
        fprintf(stderr, "kernel_launch: cus %d per_cu %d grid %d\n", cus, per_cu, grid_blocks);
    }
    if (grid_blocks < 0) return;
    Params p{};
    const float** pf = (const float**)&p;
    for (int i = 0; i < 24; ++i) pf[i] = (const float*)d_in[i];
    p.out = (float*)d_out; p.ws = (unsigned char*)d_ws;
    void* args[] = {&p};
    hipError_t e = hipLaunchCooperativeKernel((const void*)hybrid_fwd, dim3(grid_blocks), dim3(512), args, LDS_BYTES, stream);
    if (e != hipSuccess) fprintf(stderr, "kernel_launch: cooperative launch failed: %s (grid %d)\n", hipGetErrorString(e), grid_blocks);
}
```
